# Optimizing an MI355X kernel written in HIP

```python
import math
import jax, jax.numpy as jnp
from jax import lax
import numpy as np

D_MODEL = 1024
BATCH = 2
SEQ = 8192
DEPTH = 1

HYENA_WIDTH = D_MODEL // 2
HYENA_ORDER = 2
SHORT_CONV = 3
FILTER_EMB = 33
FILTER_BANDS = (FILTER_EMB - 1) // 2
FILTER_HIDDEN = 64
FILTER_SIN_FREQ = 1.0
DECAY_FAST_PCT = 0.3
DECAY_SLOW_PCT = 1.5
DECAY_TARGET = 1e-2
N_DIRECTIONS = 2
FNET_WIDTH = D_MODEL // 2
FNET_GROUPS = 4
FNET_GROUP_DIM = FNET_WIDTH // FNET_GROUPS
N_BRANCHES = 2
IN_COLS = (HYENA_ORDER + 1) * HYENA_WIDTH + FNET_WIDTH + N_BRANCHES * D_MODEL
PEER_HEADS = 8
PEER_N_KEYS = 128
PEER_EXPERTS = PEER_N_KEYS * PEER_N_KEYS
PEER_QUERY_DIM = 256
PEER_HALF = PEER_QUERY_DIM // 2
PEER_TOPK = 16
PEER_BLOCK = 128
RMS_EPS = 1e-6

kernel_name = "hyena_fnet_gated_peer_block"


def rms_norm(x, g):
    xf = x.astype(jnp.float32)
    y = xf * lax.rsqrt(jnp.mean(xf * xf, axis=-1, keepdims=True) + RMS_EPS) * g.astype(jnp.float32)
    return y.astype(x.dtype)


def short_conv(u, w, b):
    c = u.shape[-1]
    y = lax.conv_general_dilated(u, w[:, None, :].astype(u.dtype), window_strides=(1,),
                                 padding=((SHORT_CONV // 2, SHORT_CONV // 2),),
                                 dimension_numbers=('NWC', 'WIO', 'NWC'), feature_group_count=c)
    return y + b


def hyena_filter_spectrum(L, w1, b1, w2, b2, w3):
    f32 = jnp.float32
    t = jnp.linspace(0.0, 1.0, L, dtype=f32)[:, None]
    w = (2.0 * math.pi / L) * jnp.arange(L, dtype=f32)[:, None]
    bands = jnp.linspace(1e-4, FILTER_BANDS - 1, FILTER_BANDS, dtype=f32)[None, :]
    z = jnp.concatenate([t, jnp.cos(bands * w), -jnp.sin(bands * w)], axis=-1)
    hdn = jnp.sin(FILTER_SIN_FREQ * (z @ w1.astype(f32) + b1.astype(f32)))
    hdn = jnp.sin(FILTER_SIN_FREQ * (hdn @ w2.astype(f32) + b2.astype(f32)))
    h = (hdn @ w3.astype(f32)).reshape(L, HYENA_ORDER, N_DIRECTIONS, HYENA_WIDTH)
    min_decay = math.log(DECAY_TARGET) / DECAY_SLOW_PCT
    max_decay = math.log(DECAY_TARGET) / DECAY_FAST_PCT
    deltas = jnp.linspace(min_decay, max_decay, HYENA_WIDTH, dtype=f32)
    h = h * jnp.exp(-t[:, :, None, None] * jnp.abs(deltas))
    k_circ = jnp.concatenate([h[:, :, 0],
                              jnp.zeros((1, HYENA_ORDER, HYENA_WIDTH), f32),
                              h[:0:-1, :, 1]], axis=0)
    k_circ = k_circ / jnp.sum(jnp.abs(k_circ), axis=0, keepdims=True)
    return jnp.fft.rfft(k_circ, axis=0)


def fft_long_conv(u, k_f, skip):
    L = u.shape[1]
    uf = u.astype(jnp.float32)
    U = jnp.fft.rfft(uf, n=2 * L, axis=1)
    y = jnp.fft.irfft(U * k_f[None], n=2 * L, axis=1)[:, :L]
    return y + uf * skip.astype(jnp.float32)


def hyena_mixer(proj, conv_w, conv_b, w1, b1, w2, b2, w3, skip):
    L = proj.shape[1]
    u = short_conv(proj, conv_w, conv_b)
    v, x1, x2 = jnp.split(u, HYENA_ORDER + 1, axis=-1)
    k_f = hyena_filter_spectrum(L, w1, b1, w2, b2, w3)
    z = v
    for o, gate in enumerate((x1, x2)):
        z = (gate * fft_long_conv(z, k_f[:, o], skip[o])).astype(proj.dtype)
    return z


def fnet_mixer(f):
    b, L, _ = f.shape
    fg = f.astype(jnp.float32).reshape(b, L, FNET_GROUPS, FNET_GROUP_DIM)
    y = jnp.fft.fft2(fg, axes=(1, 3), norm='ortho').real
    return y.reshape(b, L, FNET_WIDTH).astype(f.dtype)


def peer_block(hb, w_q, sub_keys, u_tab, v_tab):
    T = hb.shape[0]
    q = (hb @ w_q).reshape(T, PEER_HEADS, 2, PEER_HALF)
    s = jnp.einsum('thcd,hckd->thck', q, sub_keys)
    s_top, i_top = lax.top_k(s, PEER_TOPK)
    cand = s_top[:, :, 0, :, None] + s_top[:, :, 1, None, :]
    cand_idx = i_top[:, :, 0, :, None] * PEER_N_KEYS + i_top[:, :, 1, None, :]
    best, pos = lax.top_k(cand.reshape(T, PEER_HEADS, PEER_TOPK * PEER_TOPK), PEER_TOPK)
    idx = jnp.take_along_axis(cand_idx.reshape(T, PEER_HEADS, PEER_TOPK * PEER_TOPK), pos, axis=-1)
    g = jax.nn.softmax(best.astype(jnp.float32), axis=-1)
    u_sel = jnp.take(u_tab, idx, axis=0)
    a = jax.nn.gelu(jnp.einsum('thkd,td->thk', u_sel, hb).astype(jnp.float32), approximate=False)
    v_sel = jnp.take(v_tab, idx, axis=0)
    return jnp.einsum('thk,thkd->td', (g * a).astype(hb.dtype), v_sel)


def peer_ffn(h, w_q, sub_keys, u_tab, v_tab):
    b, L, d = h.shape
    blocks = h.reshape(b * L // PEER_BLOCK, PEER_BLOCK, d)
    out = lax.map(lambda hb: peer_block(hb, w_q, sub_keys, u_tab, v_tab), blocks)
    return out.reshape(b, L, d)


def setup_inputs(seed: int = 0) -> dict:
    key = jax.random.key(seed)
    ks = jax.random.split(key, 24)
    f32 = jnp.float32
    n = lambda k, shape, scale: jax.random.normal(k, shape, f32) * scale
    HW3 = (HYENA_ORDER + 1) * HYENA_WIDTH
    return {
        "x": jax.random.normal(ks[0], (BATCH, SEQ, D_MODEL), f32),
        "norm_mix_g": 1.0 + n(ks[1], (DEPTH, D_MODEL), 0.02),
        "w_in": n(ks[2], (DEPTH, D_MODEL, IN_COLS), D_MODEL ** -0.5),
        "b_in": n(ks[3], (DEPTH, IN_COLS), 0.02),
        "conv_w": n(ks[4], (DEPTH, SHORT_CONV, HW3), SHORT_CONV ** -0.5),
        "conv_b": n(ks[5], (DEPTH, HW3), 0.02),
        "filt_w1": n(ks[6], (DEPTH, FILTER_EMB, FILTER_HIDDEN), FILTER_EMB ** -0.5),
        "filt_b1": n(ks[7], (DEPTH, FILTER_HIDDEN), 0.1),
        "filt_w2": n(ks[8], (DEPTH, FILTER_HIDDEN, FILTER_HIDDEN), FILTER_HIDDEN ** -0.5),
        "filt_b2": n(ks[9], (DEPTH, FILTER_HIDDEN), 0.1),
        "filt_w3": n(ks[10], (DEPTH, FILTER_HIDDEN, HYENA_ORDER * N_DIRECTIONS * HYENA_WIDTH), FILTER_HIDDEN ** -0.5),
        "hyena_skip": n(ks[11], (DEPTH, HYENA_ORDER, HYENA_WIDTH), 1.0),
        "w_hyena_out": n(ks[12], (DEPTH, HYENA_WIDTH, D_MODEL), HYENA_WIDTH ** -0.5),
        "w_fnet_out": n(ks[13], (DEPTH, FNET_WIDTH, D_MODEL), FNET_WIDTH ** -0.5),
        "w_out": n(ks[14], (DEPTH, D_MODEL, D_MODEL), D_MODEL ** -0.5),
        "norm_ffn_g": 1.0 + n(ks[15], (DEPTH, D_MODEL), 0.02),
        "peer_w_q": n(ks[16], (DEPTH, D_MODEL, PEER_HEADS * PEER_QUERY_DIM), D_MODEL ** -0.5),
        "peer_sub_keys": n(ks[17], (DEPTH, PEER_HEADS, 2, PEER_N_KEYS, PEER_HALF), PEER_HALF ** -0.5),
        "peer_u": n(ks[18], (DEPTH, PEER_EXPERTS, D_MODEL), D_MODEL ** -0.5),
        "peer_v": n(ks[19], (DEPTH, PEER_EXPERTS, D_MODEL), PEER_HEADS ** -0.5),
        "norm_final_g": 1.0 + n(ks[20], (D_MODEL,), 0.02),
    }


def reference(x, norm_mix_g, w_in, b_in, conv_w, conv_b, filt_w1, filt_b1, filt_w2, filt_b2, filt_w3,
              hyena_skip, w_hyena_out, w_fnet_out, w_out, norm_ffn_g, peer_w_q, peer_sub_keys,
              peer_u, peer_v, norm_final_g):
    hw3 = (HYENA_ORDER + 1) * HYENA_WIDTH
    for l in range(DEPTH):
        h = rms_norm(x, norm_mix_g[l])
        p = h @ w_in[l] + b_in[l]
        p_hy = p[..., :hw3]
        p_fn = p[..., hw3:hw3 + FNET_WIDTH]
        g_hy, g_fn = jnp.split(p[..., hw3 + FNET_WIDTH:], N_BRANCHES, axis=-1)
        z_hy = hyena_mixer(p_hy, conv_w[l], conv_b[l], filt_w1[l], filt_b1[l], filt_w2[l],
                           filt_b2[l], filt_w3[l], hyena_skip[l])
        z_fn = fnet_mixer(p_fn)
        y_hy = z_hy @ w_hyena_out[l]
        y_fn = z_fn @ w_fnet_out[l]
        merged = jax.nn.sigmoid(g_hy) * y_hy + jax.nn.sigmoid(g_fn) * y_fn
        x = x + merged @ w_out[l]
        h = rms_norm(x, norm_ffn_g[l])
        x = x + peer_ffn(h, peer_w_q[l], peer_sub_keys[l], peer_u[l], peer_v[l])
    return rms_norm(x, norm_final_g)
```

```cpp
#include <hip/hip_runtime.h>
#include <hip/hip_cooperative_groups.h>
#include <cstdio>
#include <cstdint>
namespace cg = cooperative_groups;

#ifndef N_LAUNCHES
#define N_LAUNCHES 9
#endif
#ifndef STOP_AFTER
#define STOP_AFTER 8
#endif

typedef unsigned short bf16_t;
typedef short bf16x8 __attribute__((ext_vector_type(8)));
typedef float f32x4 __attribute__((ext_vector_type(4)));
typedef float f32x2 __attribute__((ext_vector_type(2)));
typedef unsigned u32x4 __attribute__((ext_vector_type(4)));
typedef unsigned u32x2 __attribute__((ext_vector_type(2)));

#define DEV __device__ __forceinline__
#define RQ { const int lq_ = opq(lane); r = lq_ & 15; q = lq_ >> 4; }

constexpr int T_ = 16384, L_ = 8192, NT = 512, NPHASE = 9;
constexpr size_t MiB = (size_t)1 << 20;
constexpr size_t OFF_HN = 0;
constexpr size_t OFF_WIN = 32 * MiB;
constexpr size_t OFF_WQ = 40 * MiB;
constexpr size_t OFF_WOUT = 44 * MiB;
constexpr size_t OFF_WHY = 46 * MiB;
constexpr size_t OFF_WFN = 47 * MiB;
constexpr size_t OFF_W2 = 48 * MiB;
constexpr size_t OFF_W3 = 50 * MiB;
constexpr size_t OFF_KEYS = 50 * MiB + 256 * 1024;
constexpr size_t OFF_HDN2 = 50 * MiB + 768 * 1024;
constexpr size_t OFF_DT = 51 * MiB + 768 * 1024;
constexpr size_t OFF_TAB = OFF_DT + 64 * 1024;
constexpr size_t OFF_PT = 52 * MiB;
constexpr size_t OFF_HF = 116 * MiB;
constexpr size_t OFF_ZHY = 148 * MiB;
constexpr size_t OFF_PRI = 164 * MiB;
constexpr size_t OFF_U = 196 * MiB;
constexpr size_t OFF_MERGED = 52 * MiB;
constexpr size_t OFF_V = 100 * MiB;
constexpr size_t OFF_Q = 132 * MiB;
constexpr size_t OFF_IDX = 52 * MiB;
constexpr size_t OFF_G = 60 * MiB;
constexpr size_t WS_NEED = 228 * MiB;

constexpr int SMEM_BYTES = 135168;

struct Params { const float* in[21]; float* out; unsigned char* ws; int ph_lo, ph_hi; };

typedef __bf16 bf16x2_t __attribute__((ext_vector_type(2)));
DEV unsigned pk2(float lo, float hi) { f32x2 v = {lo, hi}; bf16x2_t b = __builtin_convertvector(v, bf16x2_t); return __builtin_bit_cast(unsigned, b); }
DEV float bf_lo(unsigned u) { return __uint_as_float(u << 16); }
DEV float bf_hi(unsigned u) { return __uint_as_float(u & 0xffff0000u); }
DEV float bf2f(bf16_t b) { return __uint_as_float((unsigned)b << 16); }
DEV int img_off(int row, int kc, int rows) { return (kc * rows + (row ^ (kc & 3))) << 4; }
DEV float wave_sum(float v) {
#pragma unroll
    for (int o = 32; o; o >>= 1) v += __shfl_xor(v, o);
    return v;
}
DEV f32x4 mfma16(bf16x8 a, bf16x8 b, f32x4 c) { return __builtin_amdgcn_mfma_f32_16x16x32_bf16(a, b, c, 0, 0, 0); }
DEV bf16x8 neg8(bf16x8 v) { u32x4 u = __builtin_bit_cast(u32x4, v); u ^= 0x80008000u; return __builtin_bit_cast(bf16x8, u); }
DEV int opq(int v) { asm volatile("" : "+v"(v)); return v; }
DEV float sigmoidf_(float x) { return 1.0f / (1.0f + __expf(-x)); }

template <int ROWS> struct RowLoader {
    static constexpr int NCH = ROWS * 8 / NT;
    const bf16_t* base; int ld; int tid;
    DEV void load(int t, u32x4* r) const {
#pragma unroll
        for (int i = 0; i < NCH; ++i) { const int c = tid + i * NT, row = c >> 3, kc = c & 7;
            r[i] = *(const u32x4*)(base + (size_t)row * ld + t * 64 + kc * 8); }
    }
    DEV void store(unsigned char* img, const u32x4* r) const {
        const int row = tid >> 3, kc = tid & 7;
        unsigned char* b = img + img_off(row, kc, ROWS);
#pragma unroll
        for (int i = 0; i < NCH; ++i) *(u32x4*)(b + i * 1024) = r[i];
    }
};
template <int ROWS> struct TransLoader {
    static constexpr int NU = ROWS * 4 / NT;
    static constexpr int NCH = NU * 2;
    const bf16_t* base; int ldm; int tid;
    DEV void load(int t, u32x4* r) const {
#pragma unroll
        for (int u = 0; u < NU; ++u) { const int un = tid + u * NT, mp = un % (ROWS / 2), kc = un / (ROWS / 2);
            const bf16_t* src = base + (size_t)(t * 64 + kc * 8) * ldm + 2 * mp;
            unsigned d[8];
#pragma unroll
            for (int j = 0; j < 8; ++j) d[j] = *(const unsigned*)(src + (size_t)j * ldm);
            u32x4 lo, hi;
            lo.x = (d[0] & 0xffffu) | (d[1] << 16); lo.y = (d[2] & 0xffffu) | (d[3] << 16); lo.z = (d[4] & 0xffffu) | (d[5] << 16); lo.w = (d[6] & 0xffffu) | (d[7] << 16);
            hi.x = (d[0] >> 16) | (d[1] & 0xffff0000u); hi.y = (d[2] >> 16) | (d[3] & 0xffff0000u); hi.z = (d[4] >> 16) | (d[5] & 0xffff0000u); hi.w = (d[6] >> 16) | (d[7] & 0xffff0000u);
            r[2 * u] = lo; r[2 * u + 1] = hi; }
    }
    DEV void store(unsigned char* img, const u32x4* r) const {
#pragma unroll
        for (int u = 0; u < NU; ++u) { const int un = tid + u * NT, mp = un % (ROWS / 2), kc = un / (ROWS / 2);
            *(u32x4*)(img + img_off(2 * mp, kc, ROWS)) = r[2 * u]; *(u32x4*)(img + img_off(2 * mp + 1, kc, ROWS)) = r[2 * u + 1]; }
    }
};

template <class LA, class LB>
DEV void gemm_core(const LA& la, const LB& lb, int ktiles, unsigned char* smem, f32x4 (&acc)[4][4]) {
    const int tid_ = la.tid; const int lane = tid_ & 63, w = tid_ >> 6, r = lane & 15, q = lane >> 4, wm = w >> 1, wn = w & 1;
    u32x4 ra[LA::NCH], rb[LB::NCH];
#pragma unroll
    for (int mi = 0; mi < 4; ++mi)
#pragma unroll
        for (int ni = 0; ni < 4; ++ni) acc[mi][ni] = (f32x4){0.f, 0.f, 0.f, 0.f};
    __syncthreads();
    la.load(0, ra); lb.load(0, rb);
    la.store(smem, ra); lb.store(smem + 32768, rb);
    __syncthreads();
    for (int t = 0; t < ktiles; ++t) {
        unsigned char* cur = smem + (t & 1) * 49152;
        unsigned char* nxt = smem + ((t + 1) & 1) * 49152;
        const bool more = t + 1 < ktiles;
        if (more) { la.load(t + 1, ra); lb.load(t + 1, rb); }
        const unsigned char* ca = cur + ((q * 256 + 64 * wm + (r ^ q)) << 4);
        const unsigned char* cb = cur + 32768 + ((q * 128 + 64 * wn + (r ^ q)) << 4);
#pragma unroll
        for (int s = 0; s < 2; ++s) {
            bf16x8 a[4], b[4];
#pragma unroll
            for (int mi = 0; mi < 4; ++mi) a[mi] = *(const bf16x8*)(ca + ((4 * s * 256 + 16 * mi) << 4));
#pragma unroll
            for (int ni = 0; ni < 4; ++ni) b[ni] = *(const bf16x8*)(cb + ((4 * s * 128 + 16 * ni) << 4));
#pragma unroll
            for (int mi = 0; mi < 4; ++mi)
#pragma unroll
                for (int ni = 0; ni < 4; ++ni) acc[mi][ni] = mfma16(a[mi], b[ni], acc[mi][ni]);
        }
        if (more) { la.store(nxt, ra); lb.store(nxt + 32768, rb); }
        __syncthreads();
    }
}

DEV void rms_row(const float* __restrict__ src, const float* __restrict__ g, bf16_t* __restrict__ dst, int lane) {
    f32x4 v[4]; float ss = 0.f;
#pragma unroll
    for (int i = 0; i < 4; ++i) { v[i] = *(const f32x4*)(src + 4 * lane + 256 * i); ss += v[i][0] * v[i][0] + v[i][1] * v[i][1] + v[i][2] * v[i][2] + v[i][3] * v[i][3]; }
    ss = wave_sum(ss);
    const float sc = rsqrtf(ss * (1.0f / 1024.0f) + 1e-6f);
#pragma unroll
    for (int i = 0; i < 4; ++i) { const f32x4 gg = *(const f32x4*)(g + 4 * lane + 256 * i);
        u32x2 o; o.x = pk2(v[i][0] * sc * gg[0], v[i][1] * sc * gg[1]); o.y = pk2(v[i][2] * sc * gg[2], v[i][3] * sc * gg[3]);
        *(u32x2*)(dst + 4 * lane + 256 * i) = o; }
}
DEV void transpose_tile(const float* __restrict__ src, int R, int C, int r0, int c0, bf16_t* __restrict__ dst, float* tile) {
    const int tq = opq((int)threadIdx.x); const int tx = tq & 63, ty = tq >> 6;
    __syncthreads();
#pragma unroll
    for (int i = 0; i < 8; ++i) { const int rr = ty + 8 * i; tile[rr * 65 + tx] = src[(size_t)(r0 + rr) * C + c0 + tx]; }
    __syncthreads();
#pragma unroll
    for (int i = 0; i < 8; ++i) { const int cc = ty + 8 * i; dst[(size_t)(c0 + cc) * R + r0 + tx] = (bf16_t)(pk2(tile[tx * 65 + cc], 0.f) & 0xffffu); }
}
DEV void cvt_stream(const float* __restrict__ src, bf16_t* __restrict__ dst, size_t n4) {
    for (size_t i = (size_t)blockIdx.x * NT + opq((int)threadIdx.x); i < n4; i += (size_t)gridDim.x * NT) {
        const f32x4 v = *(const f32x4*)(src + 4 * i); u32x2 o; o.x = pk2(v[0], v[1]); o.y = pk2(v[2], v[3]); *(u32x2*)(dst + 4 * i) = o; }
}

DEV void phase0(const Params& p, unsigned char* smem) {
    const int tid = opq((int)threadIdx.x), lane = tid & 63, wave = tid >> 6, nb = gridDim.x, bid = blockIdx.x;
    unsigned char* ws = p.ws;
    for (int row = bid * 8 + wave; row < T_; row += nb * 8) rms_row(p.in[0] + (size_t)row * 1024, p.in[1], (bf16_t*)(ws + OFF_HN) + (size_t)row * 1024, lane);
    for (int i = bid; i < 2080; i += nb) {
        const float* src; bf16_t* dst; int R, C, ti;
        if (i < 1024) { src = p.in[2]; dst = (bf16_t*)(ws + OFF_WIN); R = 1024; C = 4096; ti = i; }
        else if (i < 1536) { src = p.in[16]; dst = (bf16_t*)(ws + OFF_WQ); R = 1024; C = 2048; ti = i - 1024; }
        else if (i < 1792) { src = p.in[14]; dst = (bf16_t*)(ws + OFF_WOUT); R = 1024; C = 1024; ti = i - 1536; }
        else if (i < 1920) { src = p.in[12]; dst = (bf16_t*)(ws + OFF_WHY); R = 512; C = 1024; ti = i - 1792; }
        else if (i < 2048) { src = p.in[13]; dst = (bf16_t*)(ws + OFF_WFN); R = 512; C = 1024; ti = i - 1920; }
        else { src = p.in[10]; dst = (bf16_t*)(ws + OFF_W3); R = 64; C = 2048; ti = i - 2048; }
        const int tc = C / 64; transpose_tile(src, R, C, (ti / tc) * 64, (ti % tc) * 64, dst, (float*)smem);
    }
    cvt_stream(p.in[17], (bf16_t*)(ws + OFF_KEYS), 262144 / 4);
    cvt_stream(p.in[18], (bf16_t*)(ws + OFF_U), (size_t)16384 * 1024 / 4);
    {
        const float* w1 = p.in[6]; const float* b1 = p.in[7]; const float* w2 = p.in[8]; const float* b2 = p.in[9];
        bf16_t* hd = (bf16_t*)(ws + OFF_HDN2);
        for (int l = bid * 8 + wave; l < L_; l += nb * 8) {
            const float tpos = (float)l / 8191.0f, wl = 6.283185307179586f / 8192.0f * (float)l;
            float z = 0.f;
            if (lane == 0) z = tpos;
            else if (lane <= 16) { const float band = 1e-4f + (float)(lane - 1) * ((15.0f - 1e-4f) / 15.0f); z = cosf(band * wl); }
            else if (lane <= 32) { const float band = 1e-4f + (float)(lane - 17) * ((15.0f - 1e-4f) / 15.0f); z = -sinf(band * wl); }
            float a = b1[lane];
            for (int i = 0; i < 33; ++i) a += __shfl(z, i) * w1[i * 64 + lane];
            const float h1 = sinf(a);
            float c = b2[lane];
            for (int i = 0; i < 64; ++i) c += __shfl(h1, i) * w2[i * 64 + lane];
            const float h2 = sinf(c);
            hd[l * 64 + lane] = (bf16_t)(pk2(h2, 0.f) & 0xffffu);
        }
    }
    {
        bf16_t* dt = (bf16_t*)(ws + OFF_DT);
        unsigned char* tab = ws + OFF_TAB;
        for (int i = bid * NT + tid; i < 32768; i += nb * NT) {
            const int row = i >> 7, j = i & 127, c = row & 127, plane = row >> 7;
            const float x = (float)((c * j) & 127) * (1.0f / 64.0f);
            const float cv = cospif(x), sv = sinpif(x);
            dt[i] = (bf16_t)(pk2((plane ? sv : cv) * (1.0f / 1024.0f), 0.f) & 0xffffu);
            const int r128 = c, k = j;
            const int off = img_off(r128, k >> 3, 128) + (k & 7) * 2;
            *(bf16_t*)(tab + plane * 32768 + off) = (bf16_t)(pk2(plane ? sv : cv, 0.f) & 0xffffu);
        }
    }
}

DEV void phase1(const Params& p, unsigned char* smem) {
    const int tid = opq((int)threadIdx.x); const int lane = tid & 63, w = tid >> 6, r = lane & 15, q = lane >> 4, wm = w >> 1, wn = w & 1;
    unsigned char* ws = p.ws;
    const bf16_t* hn = (const bf16_t*)(ws + OFF_HN);
    const bf16_t* w_in_t = (const bf16_t*)(ws + OFF_WIN);
    const float* b_in = p.in[3];
#ifdef DBG_FOLD_ONLY
    for (int i = blockIdx.x + 2560; i < 2592; i += gridDim.x) {
#else
    for (int i = blockIdx.x; i < 2592; i += gridDim.x) {
#endif
        f32x4 acc[4][4];
        if (i < 1024) {
            const int tm = i >> 4, tn = i & 15;
            RowLoader<256> la{hn + (size_t)tm * 256 * 1024, 1024, tid}; RowLoader<128> lb{w_in_t + (size_t)tn * 128 * 1024, 1024, tid};
            gemm_core(la, lb, 16, smem, acc);
            bf16_t* pT = (bf16_t*)(ws + OFF_PT);
#pragma unroll
            for (int ni = 0; ni < 4; ++ni) { const int f = 128 * tn + 64 * wn + 16 * ni + r; const float bias = b_in[f];
#pragma unroll
                for (int mi = 0; mi < 4; ++mi) { const int t = 256 * tm + 64 * wm + 16 * mi + 4 * q; const f32x4 v = acc[mi][ni];
                    u32x2 o; o.x = pk2(v[0] + bias, v[1] + bias); o.y = pk2(v[2] + bias, v[3] + bias);
                    *(u32x2*)(pT + (size_t)f * T_ + t) = o; } }
        } else if (i < 2048) {
            const int i2 = i - 1024, tm = i2 & 7, tn = i2 >> 3;
            RowLoader<256> la{w_in_t + (size_t)(2048 + 256 * tm) * 1024, 1024, tid}; RowLoader<128> lb{hn + (size_t)tn * 128 * 1024, 1024, tid};
            gemm_core(la, lb, 16, smem, acc);
            bf16_t* sg = (bf16_t*)p.out;
#pragma unroll
            for (int mi = 0; mi < 4; ++mi) { const int f = 256 * tm + 64 * wm + 16 * mi + 4 * q; const f32x4 bias = *(const f32x4*)(b_in + 2048 + f);
#pragma unroll
                for (int ni = 0; ni < 4; ++ni) { const int t = 128 * tn + 64 * wn + 16 * ni + r; const f32x4 v = acc[mi][ni] + bias;
                    u32x2 o; o.x = pk2(sigmoidf_(v[0]), sigmoidf_(v[1])); o.y = pk2(sigmoidf_(v[2]), sigmoidf_(v[3]));
                    *(u32x2*)(sg + (size_t)t * 2048 + f) = o; } }
        } else if (i < 2560) {
            const int i3 = i - 2048, tm = i3 >> 4, tn = i3 & 15;
            RowLoader<256> la{(const bf16_t*)(ws + OFF_HDN2) + (size_t)tm * 256 * 64, 64, tid}; RowLoader<128> lb{(const bf16_t*)(ws + OFF_W3) + (size_t)tn * 128 * 64, 64, tid};
            gemm_core(la, lb, 1, smem, acc);
            bf16_t* hf = (bf16_t*)(ws + OFF_HF);
            const float min_decay = -3.0701134573253946f, max_decay = -15.350567286626973f;
#pragma unroll
            for (int ni = 0; ni < 4; ++ni) { const int col = 128 * tn + 64 * wn + 16 * ni + r, c = col & 511;
                const float delta = fabsf(min_decay + (float)c * ((max_decay - min_decay) / 511.0f));
#pragma unroll
                for (int mi = 0; mi < 4; ++mi) { const int l = 256 * tm + 64 * wm + 16 * mi + 4 * q; const f32x4 v = acc[mi][ni];
                    float e[4];
#pragma unroll
                    for (int k = 0; k < 4; ++k) e[k] = v[k] * __expf(-((float)(l + k) * (1.0f / 8191.0f)) * delta);
                    u32x2 o; o.x = pk2(e[0], e[1]); o.y = pk2(e[2], e[3]);
                    *(u32x2*)(hf + (size_t)col * L_ + l) = o; } }
        } else {
            const int i4 = i - 2560, g = i4 >> 3, tn = i4 & 7;
            RowLoader<256> la{(const bf16_t*)(ws + OFF_DT), 128, tid}; RowLoader<128> lb{(const bf16_t*)(ws + OFF_WFN) + (size_t)tn * 128 * 512 + g * 128, 512, tid};
            gemm_core(la, lb, 2, smem, acc);
            bf16_t* w2 = (bf16_t*)(ws + OFF_W2);
#pragma unroll
            for (int ni = 0; ni < 4; ++ni) { const int n = 128 * tn + 64 * wn + 16 * ni + r;
#pragma unroll
                for (int mi = 0; mi < 4; ++mi) { const int mm = 64 * wm + 16 * mi + 4 * q, plane = mm >> 7, c = mm & 127; const f32x4 v = acc[mi][ni];
                    u32x2 o; o.x = pk2(v[0], v[1]); o.y = pk2(v[2], v[3]);
                    *(u32x2*)(w2 + (size_t)n * 1024 + plane * 512 + g * 128 + c) = o; } }
        }
    }
}

template <int MI, int NI, int KS, bool REAL_IN, bool INV, bool VN>
DEV void cstep(const unsigned char* inR, const unsigned char* inI, int in_rows, int row0, const unsigned char* tabC, const unsigned char* tabS, int tmul, int col0,
               f32x4 (&aR)[MI][NI], f32x4 (&aI)[MI][NI], int lane) {
    lane = opq(lane);
    const int r = lane & 15, q = lane >> 4;
#pragma unroll
    for (int mi = 0; mi < MI; ++mi)
#pragma unroll
        for (int ni = 0; ni < NI; ++ni) { aR[mi][ni] = (f32x4){0.f, 0.f, 0.f, 0.f}; aI[mi][ni] = (f32x4){0.f, 0.f, 0.f, 0.f}; }
    const int toff = (q * 128 + col0 * tmul + ((r * tmul) ^ q)) << 4;
    const int doff = (q * in_rows + row0 + (r ^ q)) << 4;
#pragma unroll 1
    for (int s = 0; s < KS; ++s) {
        bf16x8 fc[NI], fs[NI], fn[NI];
#pragma unroll
        for (int ni = 0; ni < NI; ++ni) { const int o = toff + ((4 * s * 128 + 16 * ni * tmul) << 4);
            fc[ni] = *(const bf16x8*)(tabC + o); fs[ni] = *(const bf16x8*)(tabS + o); fn[ni] = neg8(fs[ni]); }
#pragma unroll
        for (int mi = 0; mi < MI; ++mi) {
            const int o = doff + ((4 * s * in_rows + 16 * mi) << 4);
            const bf16x8 ar = *(const bf16x8*)(inR + o);
            bf16x8 ai = ar;
            if (!REAL_IN) ai = *(const bf16x8*)(inI + o);
#pragma unroll
            for (int ni = 0; ni < NI; ++ni) {
                const bf16x8 sR = INV ? fn[ni] : fs[ni], sI = INV ? fs[ni] : fn[ni];
                if (VN) {
                    aR[mi][ni] = mfma16(fc[ni], ar, aR[mi][ni]); aI[mi][ni] = mfma16(sI, ar, aI[mi][ni]);
                    if (!REAL_IN) { aR[mi][ni] = mfma16(sR, ai, aR[mi][ni]); aI[mi][ni] = mfma16(fc[ni], ai, aI[mi][ni]); }
                } else {
                    aR[mi][ni] = mfma16(ar, fc[ni], aR[mi][ni]); aI[mi][ni] = mfma16(ar, sI, aI[mi][ni]);
                    if (!REAL_IN) { aR[mi][ni] = mfma16(ai, sR, aR[mi][ni]); aI[mi][ni] = mfma16(ai, fc[ni], aI[mi][ni]); }
                }
            }
        }
    }
}
DEV void st4(unsigned char* img, int row, int k, int rows, float a, float b, float c, float d) {
    u32x2 o; o.x = pk2(a, b); o.y = pk2(c, d); *(u32x2*)(img + img_off(row, k >> 3, rows) + (k & 7) * 2) = o;
}
DEV float sconv(const bf16_t* __restrict__ prow, int l, float w0, float w1, float w2, float cb) {
    const float pm = l > 0 ? bf2f(prow[l - 1]) : 0.f, pc = bf2f(prow[l]), pp = l < L_ - 1 ? bf2f(prow[l + 1]) : 0.f;
    return w0 * pm + w1 * pc + w2 * pp + cb;
}

DEV u32x4 pack8(const float* v) { u32x4 o; o.x = pk2(v[0], v[1]); o.y = pk2(v[2], v[3]); o.z = pk2(v[4], v[5]); o.w = pk2(v[6], v[7]); return o; }

DEV void hyena_task(const Params& p, int c, unsigned char* smem) {
    const int tid = opq((int)threadIdx.x), lane = tid & 63, w = tid >> 6; int r, q;
    unsigned char* ws = p.ws;
    const unsigned char* tabC = smem; const unsigned char* tabS = smem + 32768;
    unsigned char* dR = smem + 65536; unsigned char* dI = smem + 98304;
    float* red = (float*)(smem + 131072);
    const int row0 = 64 * (w >> 2), col0 = 32 * (w & 3), col0h = 16 * (w & 3);
    unsigned* kf = (unsigned*)(ws + OFF_HN) + (size_t)blockIdx.x * 32768;
    const bf16_t* hfT = (const bf16_t*)(ws + OFF_HF);
    const bf16_t* pT = (const bf16_t*)(ws + OFF_PT);
    bf16_t* zT = (bf16_t*)(ws + OFF_ZHY) + (size_t)c * T_;
    const float* cw = p.in[4]; const float* cbv = p.in[5]; const float* skip = p.in[11];
    const float inv16384 = 1.0f / 16384.0f;

    for (int o = 0; o < 2; ++o) {
        const bf16_t* hf = hfT + (size_t)((o * 2 + 0) * 512 + c) * L_;
        const bf16_t* hb = hfT + (size_t)((o * 2 + 1) * 512 + c) * L_;
        float part = 0.f;
        __syncthreads();
        for (int u = tid; u < 1024; u += NT) {
            const int mp = u & 63, kc = u >> 6;
            unsigned e0[8], e1[8];
#pragma unroll
            for (int j = 0; j < 8; ++j) {
                const int n1 = 8 * kc + j, n = 128 * n1 + 2 * mp;
                if (n1 < 64) { const unsigned d = *(const unsigned*)(hf + n); e0[j] = d & 0xffffu; e1[j] = d >> 16; }
                else { e0[j] = (n == 8192) ? 0u : (unsigned)hb[16384 - n]; e1[j] = (unsigned)hb[16383 - n]; }
                part += fabsf(__uint_as_float(e0[j] << 16)) + fabsf(__uint_as_float(e1[j] << 16));
            }
            u32x4 lo, hi;
            lo.x = e0[0] | (e0[1] << 16); lo.y = e0[2] | (e0[3] << 16); lo.z = e0[4] | (e0[5] << 16); lo.w = e0[6] | (e0[7] << 16);
            hi.x = e1[0] | (e1[1] << 16); hi.y = e1[2] | (e1[3] << 16); hi.z = e1[4] | (e1[5] << 16); hi.w = e1[6] | (e1[7] << 16);
            *(u32x4*)(dR + img_off(2 * mp, kc, 128)) = lo; *(u32x4*)(dR + img_off(2 * mp + 1, kc, 128)) = hi;
        }
        part = wave_sum(part);
        if (lane == 0) red[w] = part;
        __syncthreads();
        float S = 0.f;
#pragma unroll
        for (int i = 0; i < 8; ++i) S += red[i];
        const float scl = inv16384 / S;
        f32x4 aR[4][2], aI[4][2];
        cstep<4, 2, 4, true, false, false>(dR, dR, 128, row0, tabC, tabS, 1, col0, aR, aI, lane);
        __syncthreads();
        RQ
#pragma unroll
        for (int mi = 0; mi < 4; ++mi)
#pragma unroll
            for (int ni = 0; ni < 2; ++ni) { const int k1 = col0 + 16 * ni + r, n2 = row0 + 16 * mi + 4 * q; float orr[4], oi[4];
#pragma unroll
                for (int i = 0; i < 4; ++i) { const float ang = (float)((n2 + i) * k1) * inv16384; const float cs = __builtin_amdgcn_cosf(ang), sn = __builtin_amdgcn_sinf(ang);
                    const float xr = aR[mi][ni][i], xi = aI[mi][ni][i]; orr[i] = xr * cs + xi * sn; oi[i] = xi * cs - xr * sn; }
                st4(dR, k1, n2, 128, orr[0], orr[1], orr[2], orr[3]); st4(dI, k1, n2, 128, oi[0], oi[1], oi[2], oi[3]); __builtin_amdgcn_sched_barrier(0); }
        __syncthreads();
        cstep<4, 2, 4, false, false, true>(dR, dI, 128, row0, tabC, tabS, 1, col0, aR, aI, lane);
        RQ
#pragma unroll
        for (int mi = 0; mi < 4; ++mi)
#pragma unroll
            for (int ni = 0; ni < 2; ++ni) { const int k1 = row0 + 16 * mi + r, k2 = col0 + 16 * ni + 4 * q; u32x4 ov;
                ov.x = pk2(aR[mi][ni][0] * scl, aI[mi][ni][0] * scl); ov.y = pk2(aR[mi][ni][1] * scl, aI[mi][ni][1] * scl);
                ov.z = pk2(aR[mi][ni][2] * scl, aI[mi][ni][2] * scl); ov.w = pk2(aR[mi][ni][3] * scl, aI[mi][ni][3] * scl);
                *(u32x4*)(kf + o * 16384 + k1 * 128 + k2) = ov; }
    }
    const float wv0 = cw[c], wv1 = cw[1536 + c], wv2 = cw[3072 + c], cv = cbv[c];
    const float wa0 = cw[512 + c], wa1 = cw[1536 + 512 + c], wa2 = cw[3072 + 512 + c], ca = cbv[512 + c];
    const float wb0 = cw[1024 + c], wb1 = cw[1536 + 1024 + c], wb2 = cw[3072 + 1024 + c], cb = cbv[1024 + c];
    const float sk0 = skip[c], sk1 = skip[512 + c];
    const bf16_t* pv = pT + (size_t)c * T_; const bf16_t* px1 = pT + (size_t)(512 + c) * T_; const bf16_t* px2 = pT + (size_t)(1024 + c) * T_;
    __syncthreads();
    {
        const int mp = tid & 63, kc = tid >> 6;
#pragma unroll
        for (int b = 0; b < 2; ++b) {
            const bf16_t* pr = pv + b * L_;
            float u0[8], u1[8];
#pragma unroll
            for (int j = 0; j < 8; ++j) { const int l = 128 * (8 * kc + j) + 2 * mp;
                const float pm = l > 0 ? bf2f(pr[l - 1]) : 0.f; const unsigned d = *(const unsigned*)(pr + l); const float p0 = bf_lo(d), p1 = bf_hi(d);
                const float pp = (l + 2 < L_) ? bf2f(pr[l + 2]) : 0.f;
                u0[j] = wv0 * pm + wv1 * p0 + wv2 * p1 + cv; u1[j] = wv0 * p0 + wv1 * p1 + wv2 * pp + cv; }
            unsigned char* dst = b ? dI : dR;
            *(u32x4*)(dst + img_off(2 * mp, kc, 128)) = pack8(u0); *(u32x4*)(dst + img_off(2 * mp + 1, kc, 128)) = pack8(u1);
        }
    }
    __syncthreads();
    float z1r[4][4], z1i[4][4];
#pragma unroll
    for (int o = 0; o < 2; ++o) {
        f32x4 aR[4][2], aI[4][2];
        cstep<4, 2, 2, false, false, false>(dR, dI, 128, row0, tabC, tabS, 1, col0, aR, aI, lane);
        __syncthreads();
        RQ
#pragma unroll
        for (int mi = 0; mi < 4; ++mi)
#pragma unroll
            for (int ni = 0; ni < 2; ++ni) { const int k1 = col0 + 16 * ni + r, n2 = row0 + 16 * mi + 4 * q; float orr[4], oi[4];
#pragma unroll
                for (int i = 0; i < 4; ++i) { const float ang = (float)((n2 + i) * k1) * inv16384; const float cs = __builtin_amdgcn_cosf(ang), sn = __builtin_amdgcn_sinf(ang);
                    const float xr = aR[mi][ni][i], xi = aI[mi][ni][i]; orr[i] = xr * cs + xi * sn; oi[i] = xi * cs - xr * sn; }
                st4(dR, k1, n2, 128, orr[0], orr[1], orr[2], orr[3]); st4(dI, k1, n2, 128, oi[0], oi[1], oi[2], oi[3]); __builtin_amdgcn_sched_barrier(0); }
        __syncthreads();
        cstep<4, 2, 4, false, false, true>(dR, dI, 128, row0, tabC, tabS, 1, col0, aR, aI, lane);
        __syncthreads();
        RQ
#pragma unroll
        for (int mi = 0; mi < 4; ++mi)
#pragma unroll
            for (int ni = 0; ni < 2; ++ni) { const int k1 = row0 + 16 * mi + r, k2 = col0 + 16 * ni + 4 * q; float orr[4], oi[4];
                const u32x4 kk = *(const u32x4*)(kf + o * 16384 + k1 * 128 + k2);
#pragma unroll
                for (int i = 0; i < 4; ++i) { const float kr = bf_lo(kk[i]), ki = bf_hi(kk[i]); const float xr = aR[mi][ni][i], xi = aI[mi][ni][i];
                    orr[i] = xr * kr - xi * ki; oi[i] = xr * ki + xi * kr; }
                st4(dR, k1, k2, 128, orr[0], orr[1], orr[2], orr[3]); st4(dI, k1, k2, 128, oi[0], oi[1], oi[2], oi[3]); __builtin_amdgcn_sched_barrier(0); }
        __syncthreads();
        cstep<4, 2, 4, false, true, false>(dR, dI, 128, row0, tabC, tabS, 1, col0, aR, aI, lane);
        __syncthreads();
        RQ
#pragma unroll
        for (int mi = 0; mi < 4; ++mi)
#pragma unroll
            for (int ni = 0; ni < 2; ++ni) { const int n2 = col0 + 16 * ni + r, k1 = row0 + 16 * mi + 4 * q; float orr[4], oi[4];
#pragma unroll
                for (int i = 0; i < 4; ++i) { const float ang = (float)(n2 * (k1 + i)) * inv16384; const float cs = __builtin_amdgcn_cosf(ang), sn = __builtin_amdgcn_sinf(ang);
                    const float xr = aR[mi][ni][i], xi = aI[mi][ni][i]; orr[i] = xr * cs - xi * sn; oi[i] = xr * sn + xi * cs; }
                st4(dR, n2, k1, 128, orr[0], orr[1], orr[2], orr[3]); st4(dI, n2, k1, 128, oi[0], oi[1], oi[2], oi[3]); __builtin_amdgcn_sched_barrier(0); }
        __syncthreads();
        f32x4 yR[4][1], yI[4][1];
        cstep<4, 1, 4, false, true, true>(dR, dI, 128, row0, tabC, tabS, 1, col0h, yR, yI, lane);
        __syncthreads();
        RQ
#pragma unroll
        for (int mi = 0; mi < 4; ++mi) { const int n2 = row0 + 16 * mi + r, n1 = col0h + 4 * q;
            if (o == 0) {
#pragma unroll
                for (int i = 0; i < 4; ++i) { const int l = 128 * (n1 + i) + n2;
                    z1r[mi][i] = sconv(px1, l, wa0, wa1, wa2, ca) * (yR[mi][0][i] + sk0 * sconv(pv, l, wv0, wv1, wv2, cv));
                    z1i[mi][i] = sconv(px1 + L_, l, wa0, wa1, wa2, ca) * (yI[mi][0][i] + sk0 * sconv(pv + L_, l, wv0, wv1, wv2, cv)); }
                st4(dR, n2, n1, 128, z1r[mi][0], z1r[mi][1], z1r[mi][2], z1r[mi][3]); st4(dI, n2, n1, 128, z1i[mi][0], z1i[mi][1], z1i[mi][2], z1i[mi][3]);
            } else {
#pragma unroll
                for (int i = 0; i < 4; ++i) { const int l = 128 * (n1 + i) + n2;
                    const float zr = sconv(px2, l, wb0, wb1, wb2, cb) * (yR[mi][0][i] + sk1 * z1r[mi][i]);
                    const float zi = sconv(px2 + L_, l, wb0, wb1, wb2, cb) * (yI[mi][0][i] + sk1 * z1i[mi][i]);
                    zT[l] = (bf16_t)(pk2(zr, 0.f) & 0xffffu); zT[L_ + l] = (bf16_t)(pk2(zi, 0.f) & 0xffffu); }
            }
            __builtin_amdgcn_sched_barrier(0);
        }
        __syncthreads();
    }
}

DEV void fnet_task(const Params& p, int ch, unsigned char* smem) {
    const int tid = opq((int)threadIdx.x), lane = tid & 63, w = tid >> 6; int r, q;
    unsigned char* ws = p.ws;
    const unsigned char* tabC = smem; const unsigned char* tabS = smem + 32768;
    unsigned char* d0 = smem + 65536; unsigned char* d1 = smem + 98304;
    const bf16_t* src = (const bf16_t*)(ws + OFF_PT) + (size_t)(1536 + ch) * T_;
    bf16_t* PT = (bf16_t*)(ws + OFF_PRI);
    __syncthreads();
    for (int u = tid; u < 1024; u += NT) {
        const int mp = u & 63, b = (u >> 6) & 1, kc = u >> 7;
        unsigned d[8];
#pragma unroll
        for (int j = 0; j < 8; ++j) d[j] = *(const unsigned*)(src + b * L_ + 128 * (8 * kc + j) + 2 * mp);
        u32x4 lo, hi;
        lo.x = (d[0] & 0xffffu) | (d[1] << 16); lo.y = (d[2] & 0xffffu) | (d[3] << 16); lo.z = (d[4] & 0xffffu) | (d[5] << 16); lo.w = (d[6] & 0xffffu) | (d[7] << 16);
        hi.x = (d[0] >> 16) | (d[1] & 0xffff0000u); hi.y = (d[2] >> 16) | (d[3] & 0xffff0000u); hi.z = (d[4] >> 16) | (d[5] & 0xffff0000u); hi.w = (d[6] >> 16) | (d[7] & 0xffff0000u);
        *(u32x4*)(d0 + img_off(b * 128 + 2 * mp, kc, 256)) = lo; *(u32x4*)(d0 + img_off(b * 128 + 2 * mp + 1, kc, 256)) = hi;
    }
    __syncthreads();
    f32x4 aR[4][2], aI[4][2];
    {
        const int row0 = 64 * (w >> 1), col0 = 32 * (w & 1);
        cstep<4, 2, 2, true, false, false>(d0, d0, 256, row0, tabC, tabS, 2, col0, aR, aI, lane);
        __syncthreads();
        RQ
#pragma unroll
        for (int mi = 0; mi < 4; ++mi)
#pragma unroll
            for (int ni = 0; ni < 2; ++ni) { const int k1 = col0 + 16 * ni + r, rows = row0 + 16 * mi + 4 * q, n2 = rows & 127; float orr[4], oi[4];
#pragma unroll
                for (int i = 0; i < 4; ++i) { const float ang = (float)((n2 + i) * k1) * (1.0f / 8192.0f); const float cs = __builtin_amdgcn_cosf(ang), sn = __builtin_amdgcn_sinf(ang);
                    const float xr = aR[mi][ni][i], xi = aI[mi][ni][i]; orr[i] = xr * cs + xi * sn; oi[i] = xi * cs - xr * sn; }
                st4(d0, k1, rows, 64, orr[0], orr[1], orr[2], orr[3]); st4(d1, k1, rows, 64, oi[0], oi[1], oi[2], oi[3]); __builtin_amdgcn_sched_barrier(0); }
        __syncthreads();
    }
    {
        const int b = w >> 2, col0 = 32 * (w & 3);
        cstep<4, 2, 4, false, false, false>(d0 + b * 16384, d1 + b * 16384, 64, 0, tabC, tabS, 1, col0, aR, aI, lane);
        RQ
#pragma unroll
        for (int mi = 0; mi < 4; ++mi)
#pragma unroll
            for (int ni = 0; ni < 2; ++ni) { const int k2 = col0 + 16 * ni + r, k1 = 16 * mi + 4 * q; const size_t o = (size_t)ch * T_ + b * L_ + 64 * k2 + k1;
                u32x2 vr, vi; vr.x = pk2(aR[mi][ni][0], aR[mi][ni][1]); vr.y = pk2(aR[mi][ni][2], aR[mi][ni][3]); vi.x = pk2(aI[mi][ni][0], aI[mi][ni][1]); vi.y = pk2(aI[mi][ni][2], aI[mi][ni][3]);
                *(u32x2*)(PT + o) = vr; *(u32x2*)(PT + (size_t)512 * T_ + o) = vi; }
    }
}

DEV void phase2(const Params& p, unsigned char* smem) {
    __syncthreads();
    for (int i = opq((int)threadIdx.x); i < 4096; i += NT) ((u32x4*)smem)[i] = ((const u32x4*)(p.ws + OFF_TAB))[i];
    __syncthreads();
    for (int c = blockIdx.x; c < 512; c += gridDim.x) hyena_task(p, c, smem);
    for (int ch = blockIdx.x; ch < 512; ch += gridDim.x) fnet_task(p, ch, smem);
}

DEV void phase3(const Params& p, unsigned char* smem) {
    const int tid = opq((int)threadIdx.x); const int lane = tid & 63, w = tid >> 6, r = lane & 15, q = lane >> 4, wm = w >> 1, wn = w & 1;
    unsigned char* ws = p.ws;
    const bf16_t* sg = (const bf16_t*)p.out;
    bf16_t* merged = (bf16_t*)(ws + OFF_MERGED);
    for (int i = blockIdx.x; i < 512; i += gridDim.x) {
        const int tm = i & 3, tn = i >> 2;
        f32x4 acc[4][4];
        {
            RowLoader<256> la{(const bf16_t*)(ws + OFF_WHY) + (size_t)tm * 256 * 512, 512, tid}; TransLoader<128> lb{(const bf16_t*)(ws + OFF_ZHY) + tn * 128, T_, tid};
            gemm_core(la, lb, 8, smem, acc);
        }
#pragma unroll
        for (int mi = 0; mi < 4; ++mi)
#pragma unroll
            for (int ni = 0; ni < 4; ++ni) { const int f = 256 * tm + 64 * wm + 16 * mi + 4 * q, t = 128 * tn + 64 * wn + 16 * ni + r;
                const u32x2 g = *(const u32x2*)(sg + (size_t)t * 2048 + f);
                const f32x4 v = acc[mi][ni] * (f32x4){bf_lo(g.x), bf_hi(g.x), bf_lo(g.y), bf_hi(g.y)};
                u32x2 o; o.x = pk2(v[0], v[1]); o.y = pk2(v[2], v[3]);
                *(u32x2*)(merged + (size_t)t * 1024 + f) = o; }
        {
            RowLoader<256> la{(const bf16_t*)(ws + OFF_W2) + (size_t)tm * 256 * 1024, 1024, tid}; TransLoader<128> lb{(const bf16_t*)(ws + OFF_PRI) + tn * 128, T_, tid};
            gemm_core(la, lb, 16, smem, acc);
        }
#pragma unroll
        for (int mi = 0; mi < 4; ++mi)
#pragma unroll
            for (int ni = 0; ni < 4; ++ni) { const int f = 256 * tm + 64 * wm + 16 * mi + 4 * q, t = 128 * tn + 64 * wn + 16 * ni + r;
                const u32x2 g = *(const u32x2*)(sg + (size_t)t * 2048 + 1024 + f);
                const u32x2 mo = *(const u32x2*)(merged + (size_t)t * 1024 + f);
                const f32x4 v = (f32x4){bf_lo(mo.x), bf_hi(mo.x), bf_lo(mo.y), bf_hi(mo.y)} + acc[mi][ni] * (f32x4){bf_lo(g.x), bf_hi(g.x), bf_lo(g.y), bf_hi(g.y)};
                u32x2 o; o.x = pk2(v[0], v[1]); o.y = pk2(v[2], v[3]);
                *(u32x2*)(merged + (size_t)t * 1024 + f) = o; }
    }
}

DEV void phase4(const Params& p, unsigned char* smem) {
    const int tid = opq((int)threadIdx.x); const int lane = tid & 63, w = tid >> 6, r = lane & 15, q = lane >> 4, wm = w >> 1, wn = w & 1;
    unsigned char* ws = p.ws;
    for (int i = blockIdx.x; i < 512; i += gridDim.x) {
        const int tm = i & 3, tn = i >> 2;
        f32x4 acc[4][4];
        RowLoader<256> la{(const bf16_t*)(ws + OFF_WOUT) + (size_t)tm * 256 * 1024, 1024, tid}; RowLoader<128> lb{(const bf16_t*)(ws + OFF_MERGED) + (size_t)tn * 128 * 1024, 1024, tid};
        gemm_core(la, lb, 16, smem, acc);
#pragma unroll
        for (int mi = 0; mi < 4; ++mi)
#pragma unroll
            for (int ni = 0; ni < 4; ++ni) { const int f = 256 * tm + 64 * wm + 16 * mi + 4 * q, t = 128 * tn + 64 * wn + 16 * ni + r;
                const f32x4 xv = *(const f32x4*)(p.in[0] + (size_t)t * 1024 + f);
                *(f32x4*)(p.out + (size_t)t * 1024 + f) = xv + acc[mi][ni]; }
    }
}

DEV void phase5(const Params& p) {
    const int tid = opq((int)threadIdx.x); const int lane = tid & 63, wave = tid >> 6;
    for (int row = blockIdx.x * 8 + wave; row < T_; row += gridDim.x * 8) rms_row(p.out + (size_t)row * 1024, p.in[15], (bf16_t*)(p.ws + OFF_HN) + (size_t)row * 1024, lane);
    cvt_stream(p.in[19], (bf16_t*)(p.ws + OFF_V), (size_t)16384 * 1024 / 4);
}

DEV void phase6(const Params& p, unsigned char* smem) {
    const int tid = opq((int)threadIdx.x); const int lane = tid & 63, w = tid >> 6, r = lane & 15, q = lane >> 4, wm = w >> 1, wn = w & 1;
    unsigned char* ws = p.ws;
    bf16_t* qg = (bf16_t*)(ws + OFF_Q);
    for (int i = blockIdx.x; i < 1024; i += gridDim.x) {
        const int tm = i & 7, tn = i >> 3;
        f32x4 acc[4][4];
        RowLoader<256> la{(const bf16_t*)(ws + OFF_WQ) + (size_t)tm * 256 * 1024, 1024, tid}; RowLoader<128> lb{(const bf16_t*)(ws + OFF_HN) + (size_t)tn * 128 * 1024, 1024, tid};
        gemm_core(la, lb, 16, smem, acc);
#pragma unroll
        for (int mi = 0; mi < 4; ++mi)
#pragma unroll
            for (int ni = 0; ni < 4; ++ni) { const int f = 256 * tm + 64 * wm + 16 * mi + 4 * q, t = 128 * tn + 64 * wn + 16 * ni + r; const f32x4 v = acc[mi][ni];
                u32x2 o; o.x = pk2(v[0], v[1]); o.y = pk2(v[2], v[3]);
                *(u32x2*)(qg + (size_t)t * 2048 + f) = o; }
    }
}

DEV int mono(float x) { const int b = __float_as_int(x); return b ^ ((b >> 31) & 0x7fffffff); }
DEV float unmono(int k) { return __int_as_float(k ^ ((k >> 31) & 0x7fffffff)); }
#define INS16(Lk, v_) { int vv_ = (v_); _Pragma("unroll") for (int p_ = 0; p_ < 16; ++p_) { const int hi_ = max(Lk[p_], vv_); vv_ = min(Lk[p_], vv_); Lk[p_] = hi_; } }

DEV void phase7(const Params& p, unsigned char* smem) {
    const int tid = opq((int)threadIdx.x), lane = tid & 63, w = tid >> 6, r = lane & 15, q = lane >> 4;
    unsigned char* ws = p.ws;
    float* sc = (float*)smem;
    int* tops = (int*)(smem + 67584);
    const bf16_t* qg = (const bf16_t*)(ws + OFF_Q);
    const bf16_t* keys = (const bf16_t*)(ws + OFF_KEYS);
    int* idxg = (int*)(ws + OFF_IDX); float* gg = (float*)(ws + OFF_G);
    for (int item = blockIdx.x; item < 2048; item += gridDim.x) {
        const int tt = item >> 3, h = item & 7, t0 = 64 * tt;
        const int c = w >> 2, kb = 32 * (w & 3);
        f32x4 acc[4][2];
#pragma unroll
        for (int mi = 0; mi < 4; ++mi) { acc[mi][0] = (f32x4){0.f, 0.f, 0.f, 0.f}; acc[mi][1] = (f32x4){0.f, 0.f, 0.f, 0.f}; }
#pragma unroll
        for (int s = 0; s < 4; ++s) {
            bf16x8 a[4], b[2];
#pragma unroll
            for (int mi = 0; mi < 4; ++mi) a[mi] = *(const bf16x8*)(qg + (size_t)(t0 + 16 * mi + r) * 2048 + h * 256 + c * 128 + 32 * s + 8 * q);
#pragma unroll
            for (int ni = 0; ni < 2; ++ni) b[ni] = *(const bf16x8*)(keys + (size_t)((h * 2 + c) * 128 + kb + 16 * ni + r) * 128 + 32 * s + 8 * q);
#pragma unroll
            for (int mi = 0; mi < 4; ++mi) { acc[mi][0] = mfma16(a[mi], b[0], acc[mi][0]); acc[mi][1] = mfma16(a[mi], b[1], acc[mi][1]); }
        }
        __syncthreads();
#pragma unroll
        for (int mi = 0; mi < 4; ++mi)
#pragma unroll
            for (int ni = 0; ni < 2; ++ni)
#pragma unroll
                for (int i = 0; i < 4; ++i) sc[(c * 64 + 16 * mi + 4 * q + i) * 132 + kb + 16 * ni + r] = acc[mi][ni][i];
        __syncthreads();
        if (tid < 128) {
            const float* row = sc + tid * 132;
            int Lk[16];
#pragma unroll
            for (int j = 0; j < 16; ++j) Lk[j] = (int)0x80000000;
#pragma unroll 2
            for (int k4 = 0; k4 < 32; ++k4) { const f32x4 v = *(const f32x4*)(row + 4 * k4);
#pragma unroll
                for (int e = 0; e < 4; ++e) { const int key = (mono(v[e]) & ~127) | (4 * k4 + e); INS16(Lk, key); } }
#pragma unroll
            for (int j = 0; j < 16; ++j) tops[tid * 16 + j] = Lk[j];
        }
        __syncthreads();
        if (tid < 64) {
            float va[16], vb[16];
#pragma unroll
            for (int j = 0; j < 16; ++j) { va[j] = unmono(tops[tid * 16 + j] & ~127); vb[j] = unmono(tops[(64 + tid) * 16 + j] & ~127); }
            int M[16];
#pragma unroll
            for (int j = 0; j < 16; ++j) M[j] = (int)0x80000000;
#pragma unroll
            for (int i = 0; i < 16; ++i)
#pragma unroll
                for (int j = 0; j < 16; ++j)
                    if ((i + 1) * (j + 1) <= 16) { const int key = (mono(va[i] + vb[j]) & ~255) | (i << 4) | j; INS16(M, key); }
            float e[16]; float sum = 0.f; const float mx = unmono(M[0] & ~255);
#pragma unroll
            for (int k = 0; k < 16; ++k) { e[k] = __expf(unmono(M[k] & ~255) - mx); sum += e[k]; }
            const float inv = 1.0f / sum;
            const size_t ob = (size_t)(t0 + tid) * 128 + h * 16;
#pragma unroll
            for (int k = 0; k < 16; ++k) { const int ia = (M[k] >> 4) & 15, ib = M[k] & 15;
                const int ea = tops[tid * 16 + ia] & 127, eb = tops[(64 + tid) * 16 + ib] & 127;
                idxg[ob + k] = ea * 128 + eb; gg[ob + k] = e[k] * inv; }
        }
    }
}

DEV void unpack8(u32x4 v, float* o) { o[0] = bf_lo(v.x); o[1] = bf_hi(v.x); o[2] = bf_lo(v.y); o[3] = bf_hi(v.y); o[4] = bf_lo(v.z); o[5] = bf_hi(v.z); o[6] = bf_lo(v.w); o[7] = bf_hi(v.w); }
DEV void phase8(const Params& p) {
    const int tid = opq((int)threadIdx.x); const int lane = tid & 63, wave = tid >> 6;
    unsigned char* ws = p.ws;
    const int* idxg = (const int*)(ws + OFF_IDX); const float* gg = (const float*)(ws + OFF_G);
    const bf16_t* hn2 = (const bf16_t*)(ws + OFF_HN);
    const bf16_t* ut = (const bf16_t*)(ws + OFF_U); const bf16_t* vt = (const bf16_t*)(ws + OFF_V);
    const float* gfin = p.in[20];
    for (int t = blockIdx.x * 8 + wave; t < T_; t += gridDim.x * 8) {
        int ix[2]; float gw[2];
        ix[0] = idxg[(size_t)t * 128 + lane]; ix[1] = idxg[(size_t)t * 128 + 64 + lane];
        gw[0] = gg[(size_t)t * 128 + lane]; gw[1] = gg[(size_t)t * 128 + 64 + lane];
        float hv[16];
        unpack8(*(const u32x4*)(hn2 + (size_t)t * 1024 + 8 * lane), hv); unpack8(*(const u32x4*)(hn2 + (size_t)t * 1024 + 512 + 8 * lane), hv + 8);
        float wt[2];
#pragma unroll
        for (int hf = 0; hf < 2; ++hf) {
            float a = 0.f;
#pragma unroll 8
            for (int e = 0; e < 64; ++e) {
                const int ie = __builtin_amdgcn_readlane(ix[hf], e);
                const bf16_t* row = ut + (size_t)ie * 1024;
                float uv[16];
                unpack8(*(const u32x4*)(row + 8 * lane), uv); unpack8(*(const u32x4*)(row + 512 + 8 * lane), uv + 8);
                float d = 0.f;
#pragma unroll
                for (int j = 0; j < 16; ++j) d += hv[j] * uv[j];
                d = wave_sum(d);
                if (lane == e) a = d;
            }
            wt[hf] = gw[hf] * 0.5f * a * (1.0f + erff(a * 0.70710678118654752f));
        }
        float acc[16];
#pragma unroll
        for (int j = 0; j < 16; ++j) acc[j] = 0.f;
#pragma unroll
        for (int hf = 0; hf < 2; ++hf) {
#pragma unroll 8
            for (int e = 0; e < 64; ++e) {
                const int ie = __builtin_amdgcn_readlane(ix[hf], e);
                const float we = __int_as_float(__builtin_amdgcn_readlane(__float_as_int(wt[hf]), e));
                const bf16_t* row = vt + (size_t)ie * 1024;
                float vv[16];
                unpack8(*(const u32x4*)(row + 8 * lane), vv); unpack8(*(const u32x4*)(row + 512 + 8 * lane), vv + 8);
#pragma unroll
                for (int j = 0; j < 16; ++j) acc[j] += we * vv[j];
            }
        }
        float* xo = p.out + (size_t)t * 1024;
        float ss = 0.f;
#pragma unroll
        for (int k = 0; k < 4; ++k) { const f32x4 xv = *(const f32x4*)(xo + (k >> 1) * 512 + 8 * lane + (k & 1) * 4);
#pragma unroll
            for (int j = 0; j < 4; ++j) { acc[4 * k + j] += xv[j]; ss += acc[4 * k + j] * acc[4 * k + j]; } }
        ss = wave_sum(ss);
        const float scn = rsqrtf(ss * (1.0f / 1024.0f) + 1e-6f);
#pragma unroll
        for (int k = 0; k < 4; ++k) { const int off = (k >> 1) * 512 + 8 * lane + (k & 1) * 4; const f32x4 gv = *(const f32x4*)(gfin + off);
            f32x4 o; o[0] = acc[4 * k] * scn * gv[0]; o[1] = acc[4 * k + 1] * scn * gv[1]; o[2] = acc[4 * k + 2] * scn * gv[2]; o[3] = acc[4 * k + 3] * scn * gv[3];
            *(f32x4*)(xo + off) = o; }
    }
}

__global__ void __launch_bounds__(NT) fwd_kernel(Params p) {
    __shared__ __attribute__((aligned(16))) unsigned char smem[SMEM_BYTES];
    for (int ph = p.ph_lo; ph < p.ph_hi; ++ph) {
#ifndef PHASE_MASK
#define PHASE_MASK 0x1ff
#endif
        switch (ph) {
#if PHASE_MASK & 1
            case 0: phase0(p, smem); break;
#endif
#if PHASE_MASK & 2
            case 1: phase1(p, smem); break;
#endif
#if PHASE_MASK & 4
            case 2: phase2(p, smem); break;
#endif
#if PHASE_MASK & 8
            case 3: phase3(p, smem); break;
#endif
#if PHASE_MASK & 16
            case 4: phase4(p, smem); break;
#endif
#if PHASE_MASK & 32
            case 5: phase5(p); break;
#endif
#if PHASE_MASK & 64
            case 6: phase6(p, smem); break;
#endif
#if PHASE_MASK & 128
            case 7: phase7(p, smem); break;
#endif
#if PHASE_MASK & 256
            case 8: phase8(p); break;
#endif
            default: break;
        }
        if (ph + 1 < p.ph_hi) cg::this_grid().sync();
    }
}


#ifdef DUMP_A
__global__ void dump_kernel(const bf16_t* a, const bf16_t* b, float* out) {
    const size_t half = (size_t)8388608;
    for (size_t i = (size_t)blockIdx.x * blockDim.x + threadIdx.x; i < 2 * half; i += (size_t)gridDim.x * blockDim.x)
        { float v = i < (size_t)DUMP_N ? bf2f(a[i]) : 0.f; out[i] = (v == v && fabsf(v) < 1e30f) ? v : 12345.0f; }
}
#endif
extern "C" void kernel_launch(void* const* d_in, const int* in_sizes, int n_in, void* d_out, int out_size, void* d_ws, size_t ws_size, hipStream_t stream) {
    static int grid = 0;
    if (grid == 0) {
        if (n_in != 21 || out_size != T_ * 1024 || ws_size < WS_NEED) { fprintf(stderr, "kernel_launch: unexpected problem (n_in %d, out %d, ws %zu)\n", n_in, out_size, ws_size); grid = -1; return; }
        int dev = 0, cus = 0, per_cu = 0;
        (void)hipGetDevice(&dev);
        (void)hipDeviceGetAttribute(&cus, hipDeviceAttributeMultiprocessorCount, dev);
        (void)hipOccupancyMaxActiveBlocksPerMultiprocessor(&per_cu, (const void*)fwd_kernel, NT, 0);
        if (per_cu < 1 || cus < 1) { fprintf(stderr, "kernel_launch: occupancy query says %d blocks/CU on %d CUs\n", per_cu, cus); grid = -1; return; }
        grid = cus > 256 ? 256 : cus;
    }
    if (grid < 0) return;
    Params p{};
    for (int i = 0; i < 21; ++i) p.in[i] = (const float*)d_in[i];
    p.out = (float*)d_out; p.ws = (unsigned char*)d_ws;
#if N_LAUNCHES == 1
    p.ph_lo = 0; p.ph_hi = NPHASE;
    void* args[] = {&p};
    hipError_t e = hipLaunchCooperativeKernel((const void*)fwd_kernel, dim3(grid), dim3(NT), args, 0, stream);
    if (e != hipSuccess) fprintf(stderr, "cooperative launch failed: %s (grid %d)\n", hipGetErrorString(e), grid);
#else
    for (int ph = 0; ph <= STOP_AFTER && ph < NPHASE; ++ph) { p.ph_lo = ph; p.ph_hi = ph + 1; hipLaunchKernelGGL(fwd_kernel, dim3(grid), dim3(NT), 0, stream, p); }
#ifdef DUMP_A
    hipLaunchKernelGGL(dump_kernel, dim3(1024), dim3(256), 0, stream, (const bf16_t*)((unsigned char*)d_ws + DUMP_A), (const bf16_t*)((unsigned char*)d_ws + DUMP_B), (float*)d_out);
#endif
#endif
}
```

```cpp
#include <hip/hip_runtime.h>
#include <cstdio>
#include <cstdint>

#ifndef N_LAUNCHES
#define N_LAUNCHES 1
#endif

typedef unsigned short bf16_t;
typedef short bf16x8 __attribute__((ext_vector_type(8)));
typedef float f32x4 __attribute__((ext_vector_type(4)));
typedef float f32x2 __attribute__((ext_vector_type(2)));
typedef unsigned u32x4 __attribute__((ext_vector_type(4)));
typedef unsigned u32x2 __attribute__((ext_vector_type(2)));

#define DEV __device__ __forceinline__
#define RQ { const int lq_ = opq(lane); r = lq_ & 15; q = lq_ >> 4; }

constexpr int T_ = 16384, L_ = 8192, NT = 512, NPHASE = 8;
constexpr size_t MiB = (size_t)1 << 20;
constexpr size_t OFF_HN = 0;
constexpr size_t OFF_WIN = 32 * MiB;
constexpr size_t OFF_WQ = 40 * MiB;
constexpr size_t OFF_WOUT = 44 * MiB;
constexpr size_t OFF_WHY = 46 * MiB;
constexpr size_t OFF_WFN = 47 * MiB;
constexpr size_t OFF_W2 = 48 * MiB;
constexpr size_t OFF_W3 = 50 * MiB;
constexpr size_t OFF_KEYS = 50 * MiB + 256 * 1024;
constexpr size_t OFF_HDN2 = 50 * MiB + 768 * 1024;
constexpr size_t OFF_DT = 51 * MiB + 768 * 1024;
constexpr size_t OFF_TAB = OFF_DT + 64 * 1024;
constexpr size_t OFF_PT = 52 * MiB;
constexpr size_t OFF_HF = 116 * MiB;
constexpr size_t OFF_ZHY = 148 * MiB;
constexpr size_t OFF_PRI = 164 * MiB;
constexpr size_t OFF_U = 196 * MiB;
constexpr size_t OFF_US = 212 * MiB;
constexpr size_t OFF_SS1 = 212 * MiB + 64 * 1024;
constexpr size_t OFF_BAR = 51 * MiB + 896 * 1024;
constexpr size_t OFF_ZR = 84 * MiB;
constexpr size_t OFF_PR = 116 * MiB;
constexpr size_t OFF_MERGED = 52 * MiB;
constexpr size_t OFF_V = 240 * MiB;
constexpr size_t OFF_VS = 212 * MiB + 256 * 1024;
constexpr size_t OFF_IDX = 216 * MiB;
constexpr size_t OFF_G = 224 * MiB;
constexpr size_t OFF_PO = 52 * MiB;
constexpr size_t OFF_XQ = 84 * MiB;
constexpr size_t OFF_HS = 100 * MiB;
constexpr size_t OFF_USC = 216 * MiB;
constexpr size_t WS_NEED = 256 * MiB;

constexpr int SMEM_BYTES = 151552;

struct Params { const float* in[21]; float* out; unsigned char* ws; int ph_lo, ph_hi; };
#define GPTR __attribute__((address_space(1)))
struct GParams { const GPTR float* in[21]; GPTR float* out; GPTR unsigned char* ws; int ph_lo, ph_hi; };
typedef const __attribute__((address_space(4))) GParams CParams;
#define PIN(k) ((const float*)p.in[k])
#define POUT ((float*)p.out)
#define PWS ((unsigned char*)p.ws)

typedef __bf16 bf16x2_t __attribute__((ext_vector_type(2)));
DEV unsigned pk2(float lo, float hi) { f32x2 v = {lo, hi}; bf16x2_t b = __builtin_convertvector(v, bf16x2_t); return __builtin_bit_cast(unsigned, b); }
DEV float bf_lo(unsigned u) { return __uint_as_float(u << 16); }
DEV float bf_hi(unsigned u) { return __uint_as_float(u & 0xffff0000u); }
DEV float bf2f(bf16_t b) { return __uint_as_float((unsigned)b << 16); }
DEV int img_off(int row, int kc, int rows) { return (kc * rows + (row ^ (kc & 3))) << 4; }
DEV float wave_sum(float v) {
#pragma unroll
    for (int o = 32; o; o >>= 1) v += __shfl_xor(v, o);
    return v;
}
DEV f32x4 mfma16(bf16x8 a, bf16x8 b, f32x4 c) { return __builtin_amdgcn_mfma_f32_16x16x32_bf16(a, b, c, 0, 0, 0); }
DEV bf16x8 neg8(bf16x8 v) { u32x4 u = __builtin_bit_cast(u32x4, v); u ^= 0x80008000u; return __builtin_bit_cast(bf16x8, u); }
template <class T> DEV T* opqp(T* p) { __attribute__((address_space(1))) T* g = (__attribute__((address_space(1))) T*)p; asm volatile("" : "+s"(g)); return (T*)g; }
DEV int opqs(int v) { asm volatile("" : "+s"(v)); return v; }
#define BID() opqs((int)blockIdx.x)
#define NBLK() opqs((int)gridDim.x)
DEV int opq(int v) { asm volatile("" : "+v"(v)); return v; }
DEV void lds_barrier() { asm volatile("s_waitcnt lgkmcnt(0)" ::: "memory"); __builtin_amdgcn_s_barrier(); asm volatile("" ::: "memory"); }
DEV float sigmoidf_(float x) { return 1.0f / (1.0f + __expf(-x)); }

template <int ROWS> struct RowLoader {
    static constexpr int NCH = ROWS * 8 / NT;
    const bf16_t* base; int ld; int tid;
    DEV void load(int t, u32x4* r) const {
#pragma unroll
        for (int i = 0; i < NCH; ++i) { const int c = tid + i * NT, row = c >> 3, kc = c & 7;
            r[i] = *(const u32x4*)(base + (size_t)row * ld + t * 64 + kc * 8); }
    }
    DEV void store(unsigned char* img, const u32x4* r) const {
        const int row = tid >> 3, kc = tid & 7;
        unsigned char* b = img + img_off(row, kc, ROWS);
#pragma unroll
        for (int i = 0; i < NCH; ++i) *(u32x4*)(b + i * 1024) = r[i];
    }
};
template <class LA, class LB>
DEV void gemm_core(const LA& la, const LB& lb, int ktiles, unsigned char* smem, f32x4 (&acc)[4][4]) {
    const int tid_ = la.tid; const int lane = tid_ & 63, w = tid_ >> 6, r = lane & 15, q = lane >> 4, wm = w >> 1, wn = w & 1;
    u32x4 ra[LA::NCH], rb[LB::NCH];
#pragma unroll
    for (int mi = 0; mi < 4; ++mi)
#pragma unroll
        for (int ni = 0; ni < 4; ++ni) acc[mi][ni] = (f32x4){0.f, 0.f, 0.f, 0.f};
    __syncthreads();
    la.load(0, ra); lb.load(0, rb);
    la.store(smem, ra); lb.store(smem + 32768, rb);
    __syncthreads();
    for (int t = 0; t < ktiles; ++t) {
        unsigned char* cur = smem + (t & 1) * 49152;
        unsigned char* nxt = smem + ((t + 1) & 1) * 49152;
        const bool more = t + 1 < ktiles;
        if (more) { la.load(t + 1, ra); lb.load(t + 1, rb); }
        const unsigned char* ca = cur + ((q * 256 + 64 * wm + (r ^ q)) << 4);
        const unsigned char* cb = cur + 32768 + ((q * 128 + 64 * wn + (r ^ q)) << 4);
#pragma unroll
        for (int s = 0; s < 2; ++s) {
            bf16x8 a[4], b[4];
#pragma unroll
            for (int mi = 0; mi < 4; ++mi) a[mi] = *(const bf16x8*)(ca + ((4 * s * 256 + 16 * mi) << 4));
#pragma unroll
            for (int ni = 0; ni < 4; ++ni) b[ni] = *(const bf16x8*)(cb + ((4 * s * 128 + 16 * ni) << 4));
#pragma unroll
            for (int mi = 0; mi < 4; ++mi)
#pragma unroll
                for (int ni = 0; ni < 4; ++ni) acc[mi][ni] = mfma16(a[mi], b[ni], acc[mi][ni]);
        }
        if (more) { la.store(nxt, ra); lb.store(nxt + 32768, rb); }
        __syncthreads();
    }
}

namespace pg8 {
#define PG8_LAS __attribute__((address_space(3)))
typedef unsigned short bf16_t;
typedef short bf16x8 __attribute__((ext_vector_type(8)));
typedef float f32x4 __attribute__((ext_vector_type(4)));
typedef unsigned u32x4 __attribute__((ext_vector_type(4)));
constexpr int BM = 256, BK = 64, HALF = 128, HTB = HALF * BK * 2  , STAGE_BYTES = 8 * HTB, NXCD = 8, WGM = 8;

__host__ __device__ __forceinline__ int lds_byte(int r, int c) { const int st = (r >> 4) * 2 + (c >> 5), rr = r & 15, cc = c & 31, ob = rr * 64 + cc * 2; return st * 1024 + (ob ^ (((ob >> 9) & 1) << 5)); }
__host__ __device__ __forceinline__ void stage_rc(int b, int& R, int& C) { const int st = b / 1024, sb = b % 1024, swz = sb ^ (((sb >> 9) & 1) << 5); R = (st >> 1) * 16 + swz / 64; C = (st & 1) * 32 + (swz % 64) / 2; }
__host__ __device__ __forceinline__ int perm32(int rho) { const int n = rho >> 4, i = rho & 15; return 8 * (i >> 2) + 4 * n + (i & 3); }

struct Unit { int pm, pn; };
struct Gemm { const bf16_t* A; const bf16_t* Bt; int M, N, K; };

struct StaticOrder {
    int nM, nN, nwg, G, c;
    __host__ __device__ void init(int M, int N, int G_, int c_) { nM = M / BM; nN = N / BM; nwg = nM * nN; G = G_; c = c_; }
    __host__ __device__ bool next(int i, Unit& u) const {
        const long L = (long)i * G + c; if (L >= nwg) return false;
        int wgid = (int)L; { const int q = nwg / NXCD, r = nwg % NXCD, xcd = wgid % NXCD, off = wgid / NXCD; wgid = (xcd < r ? xcd * (q + 1) : r * (q + 1) + (xcd - r) * q) + off; }
        const int nig = WGM * nN, gid = wgid / nig, fm = gid * WGM, gsz = (nM - fm) < WGM ? (nM - fm) : WGM;
        u.pm = fm + ((wgid % nig) % gsz); u.pn = (wgid % nig) / gsz; return true;
    }
    __device__ __forceinline__ void a_ready(const Unit&) const {}
    __device__ __forceinline__ void done(const Unit&) const {}
};

template <class Epi, class Sched, bool ALIGN_EPI = false, bool SP2 = false>
__device__ __forceinline__ void gemm_phase(PG8_LAS unsigned char* lds, const Gemm g, const Sched& S, const Epi& E) {
    const int tid = opq((int)threadIdx.x), wid = __builtin_amdgcn_readfirstlane(tid >> 6), lane = tid & 63, wr = wid >> 2, wc = wid & 3, fr = lane & 15, fq = lane >> 4;
    const int K = g.K, nt = K / BK;
    unsigned voffA[2], voffB[2];
#pragma unroll
    for (int i = 0; i < 2; ++i) { int R, C; stage_rc(tid * 16 + i * 8192, R, C); const int Rb = Epi::PERM ? ((R & ~31) + perm32(R & 31)) : R;
        voffA[i] = (unsigned)(R * K + C) * 2u; voffB[i] = (unsigned)(Rb * K + C) * 2u; }
    const size_t kstep = (size_t)(BK * 2);
    const size_t hstep = (size_t)HALF * K * 2;
    const size_t tstep = 2 * hstep;
    const unsigned ldsw = (unsigned)wid * 1024u;
    const int aoff = lds_byte(wr * 64 + fr, fq * 8), boff = lds_byte(wc * 32 + fr, fq * 8);
#define PG8_SA(b, h) (((b) * 2 + (h)) * HTB)
#define PG8_SB(b, h) ((4 + (b) * 2 + (h)) * HTB)
#define PG8_STAGE(bufoff, gbase, voff) do { _Pragma("unroll") for (int _i = 0; _i < 2; ++_i) \
        __builtin_amdgcn_global_load_lds((const unsigned*)((const char*)(gbase) + (voff)[_i]), (PG8_LAS unsigned*)(lds + (bufoff) + ldsw + _i * 8192), 16, 0, 0); } while (0)
#define PG8_LDA(dst, b, h) do { _Pragma("unroll") for (int m = 0; m < 4; ++m) _Pragma("unroll") for (int k = 0; k < 2; ++k) dst[m][k] = *(const PG8_LAS bf16x8*)(lds + PG8_SA(b, h) + aoff + m * 2048 + k * 1024); } while (0)
#define PG8_LDB(dst, b, h) do { _Pragma("unroll") for (int n = 0; n < 2; ++n) _Pragma("unroll") for (int k = 0; k < 2; ++k) dst[n][k] = *(const PG8_LAS bf16x8*)(lds + PG8_SB(b, h) + boff + n * 2048 + k * 1024); } while (0)
#define PG8_MMA(ai, bj, At, Bt) do { __builtin_amdgcn_s_setprio(1); _Pragma("unroll") for (int m = 0; m < 4; ++m) _Pragma("unroll") for (int n = 0; n < 2; ++n) _Pragma("unroll") for (int k = 0; k < 2; ++k) \
        acc[ai][bj][m][n] = __builtin_amdgcn_mfma_f32_16x16x32_bf16(Bt[n][k], At[m][k], acc[ai][bj][m][n], 0, 0, 0); __builtin_amdgcn_s_setprio(0); } while (0)
#define PG8_WAIT_V(n) asm volatile("s_waitcnt vmcnt(" #n ")" ::: "memory")
#define PG8_WAIT_L(n) asm volatile("s_waitcnt lgkmcnt(" #n ")" ::: "memory")
#define PG8_BAR __builtin_amdgcn_s_barrier()
#define PG8_SCHED __builtin_amdgcn_sched_barrier(0)
    Unit cur, nxt; int ui = 0;
    if (!S.next(0, cur)) return;
    f32x4 acc[2][2][4][2];
#pragma unroll
    for (int a = 0; a < 2; ++a)
#pragma unroll
        for (int b = 0; b < 2; ++b)
#pragma unroll
            for (int m = 0; m < 4; ++m)
#pragma unroll
                for (int n = 0; n < 2; ++n) acc[a][b][m][n] = (f32x4){0.f, 0.f, 0.f, 0.f};
    bf16x8 At[4][2], B0[2][2], B1[2][2];
    const char* cA = (const char*)g.A + (size_t)cur.pm * tstep; const char* cB = (const char*)g.Bt + (size_t)cur.pn * tstep;
    S.a_ready(cur);
    if constexpr (SP2) {
        PG8_STAGE(PG8_SB(0, 0), cB, voffB); PG8_STAGE(PG8_SB(0, 1), cB + hstep, voffB); PG8_STAGE(PG8_SA(0, 0), cA, voffA); PG8_STAGE(PG8_SA(0, 1), cA + hstep, voffA);
        if (wr == 1) PG8_BAR;
        PG8_WAIT_V(2); PG8_BAR;
        PG8_STAGE(PG8_SB(1, 0), cB + kstep, voffB); PG8_STAGE(PG8_SA(1, 0), cA + kstep, voffA); PG8_STAGE(PG8_SB(1, 1), cB + hstep + kstep, voffB);
        PG8_WAIT_V(6); PG8_BAR;
    } else {
        PG8_STAGE(PG8_SB(0, 0), cB, voffB); PG8_STAGE(PG8_SA(0, 0), cA, voffA); PG8_STAGE(PG8_SB(0, 1), cB + hstep, voffB); PG8_STAGE(PG8_SA(0, 1), cA + hstep, voffA);
        if (wr == 1) PG8_BAR;
        PG8_WAIT_V(4); PG8_BAR;
        PG8_STAGE(PG8_SB(1, 0), cB + kstep, voffB); PG8_STAGE(PG8_SA(1, 0), cA + kstep, voffA); PG8_STAGE(PG8_SB(1, 1), cB + hstep + kstep, voffB);
        PG8_WAIT_V(6); PG8_BAR;
    }
    for (;;) {
        const bool has_next = S.next(ui + 1, nxt);
        const char* nA = has_next ? (const char*)g.A + (size_t)nxt.pm * tstep : cA; const char* nB = has_next ? (const char*)g.Bt + (size_t)nxt.pn * tstep : cB;
        for (int t = 0; t < nt; t += 2) {
            const bool last = (t == nt - 2);
            const char* a1 = cA + (size_t)(t + 1) * kstep;
            const char* a2 = last ? nA : cA + (size_t)(t + 2) * kstep; const char* b2 = last ? nB : cB + (size_t)(t + 2) * kstep;
            const char* a3 = a2 + kstep; const char* b3 = b2 + kstep;
            if (last && has_next) S.a_ready(nxt);
            if constexpr (SP2) {
            PG8_LDB(B0, 0, 0); PG8_LDB(B1, 0, 1); PG8_SCHED; PG8_LDA(At, 0, 0); PG8_STAGE(PG8_SA(1, 1), a1 + hstep, voffA);
            PG8_WAIT_V(8); PG8_WAIT_L(0); PG8_BAR; PG8_MMA(0, 0, At, B0); PG8_MMA(0, 1, At, B1); PG8_BAR; PG8_SCHED;
            PG8_LDA(At, 0, 1); PG8_STAGE(PG8_SB(0, 0), b2, voffB); PG8_STAGE(PG8_SB(0, 1), b2 + hstep, voffB); PG8_STAGE(PG8_SA(0, 0), a2, voffA);
            PG8_WAIT_V(8); PG8_WAIT_L(0); PG8_BAR; PG8_MMA(1, 0, At, B0); PG8_MMA(1, 1, At, B1); PG8_BAR; PG8_SCHED;
            PG8_LDB(B0, 1, 0); PG8_LDB(B1, 1, 1); PG8_SCHED; PG8_LDA(At, 1, 0); PG8_STAGE(PG8_SA(0, 1), a2 + hstep, voffA);
            PG8_WAIT_V(8); PG8_WAIT_L(0); PG8_BAR; PG8_MMA(0, 0, At, B0); PG8_MMA(0, 1, At, B1); PG8_BAR; PG8_SCHED;
            PG8_LDA(At, 1, 1); PG8_STAGE(PG8_SB(1, 0), b3, voffB); PG8_STAGE(PG8_SB(1, 1), b3 + hstep, voffB); PG8_STAGE(PG8_SA(1, 0), a3, voffA);
            PG8_WAIT_V(8); PG8_WAIT_L(0); PG8_BAR; PG8_MMA(1, 0, At, B0); PG8_MMA(1, 1, At, B1); PG8_BAR; PG8_SCHED;
            } else {
            PG8_LDB(B0, 0, 0); PG8_SCHED; PG8_LDA(At, 0, 0); PG8_STAGE(PG8_SA(1, 1), a1 + hstep, voffA);
            PG8_WAIT_L(8); PG8_BAR; PG8_WAIT_L(0); PG8_MMA(0, 0, At, B0); PG8_BAR; PG8_SCHED;
            PG8_LDB(B1, 0, 1); PG8_STAGE(PG8_SB(0, 0), b2, voffB);
            PG8_BAR; PG8_WAIT_L(0); PG8_MMA(0, 1, At, B1); PG8_BAR;
            PG8_LDA(At, 0, 1); PG8_STAGE(PG8_SA(0, 0), a2, voffA);
            PG8_BAR; PG8_WAIT_L(0); PG8_MMA(1, 0, At, B0); PG8_BAR; PG8_SCHED;
            PG8_STAGE(PG8_SB(0, 1), b2 + hstep, voffB);
            PG8_WAIT_V(6); PG8_BAR; PG8_MMA(1, 1, At, B1); PG8_BAR;
            PG8_LDB(B0, 1, 0); PG8_SCHED; PG8_LDA(At, 1, 0); PG8_STAGE(PG8_SA(0, 1), a2 + hstep, voffA);
            PG8_WAIT_L(8); PG8_BAR; PG8_WAIT_L(0); PG8_MMA(0, 0, At, B0); PG8_BAR; PG8_SCHED;
            PG8_LDB(B1, 1, 1); PG8_STAGE(PG8_SB(1, 0), b3, voffB);
            PG8_BAR; PG8_WAIT_L(0); PG8_MMA(0, 1, At, B1); PG8_BAR;
            PG8_LDA(At, 1, 1); PG8_STAGE(PG8_SA(1, 0), a3, voffA);
            PG8_BAR; PG8_WAIT_L(0); PG8_MMA(1, 0, At, B0); PG8_BAR; PG8_SCHED;
            PG8_STAGE(PG8_SB(1, 1), b3 + hstep, voffB);
            PG8_WAIT_V(6); PG8_BAR; PG8_MMA(1, 1, At, B1); PG8_BAR;
            }
        }
        if constexpr (ALIGN_EPI) { if (wr == 0) PG8_BAR; }
        if constexpr (!Epi::AFTER_DRAIN) { E(acc, cur, wr, wc, fr, fq); S.done(cur); }
        if (!has_next) break;
#pragma unroll
        for (int a = 0; a < 2; ++a)
#pragma unroll
            for (int b = 0; b < 2; ++b)
#pragma unroll
                for (int m = 0; m < 4; ++m)
#pragma unroll
                    for (int n = 0; n < 2; ++n) acc[a][b][m][n] = (f32x4){0.f, 0.f, 0.f, 0.f};
        cur = nxt; cA = nA; cB = nB; ++ui;
        if constexpr (ALIGN_EPI) { if (wr == 1) PG8_BAR; }
    }
    PG8_WAIT_V(0);
    if constexpr (!ALIGN_EPI) { if (wr == 0) PG8_BAR; }
    PG8_BAR;
    if constexpr (Epi::AFTER_DRAIN) { E.fused(acc, cur, wr, wc, fr, fq, lds, wid, lane); S.done(cur); }
#undef PG8_SA
#undef PG8_SB
#undef PG8_STAGE
#undef PG8_LDA
#undef PG8_LDB
#undef PG8_MMA
#undef PG8_WAIT_V
#undef PG8_WAIT_L
#undef PG8_BAR
#undef PG8_SCHED
}
}

template <class F> struct Epi8 {
    static constexpr bool PERM = true, AFTER_DRAIN = false;
    F f;
    __device__ __forceinline__ void operator()(const pg8::f32x4 (&acc)[2][2][4][2], const pg8::Unit& u, int wr, int wc, int fr, int fq) const {
        fr = opq(fr); fq = opq(fq);
#pragma unroll
        for (int ai = 0; ai < 2; ++ai)
#pragma unroll
            for (int m = 0; m < 4; ++m) { const int row = u.pm * 256 + ai * 128 + wr * 64 + m * 16 + fr;
#pragma unroll
                for (int bj = 0; bj < 2; ++bj) { const int col0 = u.pn * 256 + bj * 128 + wc * 32 + 8 * fq; f(row, col0, acc[ai][bj][m][0], acc[ai][bj][m][1]); } }
    }
};
template <class F> DEV void run_gemm(unsigned char* smem, const bf16_t* A, const bf16_t* Bt, int M, int N, int K, const F& f) {
    A = opqp(A); Bt = opqp(Bt);
    pg8::Gemm g{A, Bt, M, N, K};
    pg8::StaticOrder S; S.init(M, N, (int)NBLK(), (int)BID());
    Epi8<F> E{f};
    __syncthreads();
    pg8::gemm_phase<Epi8<F>, pg8::StaticOrder, true, true>((PG8_LAS unsigned char*)smem, g, S, E);
    __syncthreads();
}
DEV u32x4 pack8v(f32x4 a, f32x4 b) { u32x4 o; o.x = pk2(a[0], a[1]); o.y = pk2(a[2], a[3]); o.z = pk2(b[0], b[1]); o.w = pk2(b[2], b[3]); return o; }
DEV void unpack8v(u32x4 v, f32x4& a, f32x4& b) { a = (f32x4){bf_lo(v.x), bf_hi(v.x), bf_lo(v.y), bf_hi(v.y)}; b = (f32x4){bf_lo(v.z), bf_hi(v.z), bf_lo(v.w), bf_hi(v.w)}; }

DEV void rms_rows4(const float* __restrict__ src, const float* __restrict__ g, bf16_t* __restrict__ dst, int row0, int lane) {
    f32x4 v[4][4]; float ss[4];
    const float eps_ = __int_as_float(opq(__float_as_int(1e-6f)));

#pragma unroll
    for (int k = 0; k < 4; ++k)
#pragma unroll
        for (int i = 0; i < 4; ++i) v[k][i] = *(const f32x4*)(src + (size_t)(row0 + k) * 1024 + 4 * lane + 256 * i);
#pragma unroll
    for (int k = 0; k < 4; ++k) { ss[k] = 0.f;
#pragma unroll
        for (int i = 0; i < 4; ++i) ss[k] += v[k][i][0] * v[k][i][0] + v[k][i][1] * v[k][i][1] + v[k][i][2] * v[k][i][2] + v[k][i][3] * v[k][i][3]; }
#pragma unroll
    for (int o = 32; o; o >>= 1) {
#pragma unroll
        for (int k = 0; k < 4; ++k) ss[k] += __shfl_xor(ss[k], o); }
#pragma unroll
    for (int i = 0; i < 4; ++i) { const f32x4 gg = *(const f32x4*)(g + 4 * lane + 256 * i);
#pragma unroll
        for (int k = 0; k < 4; ++k) { const float sc = rsqrtf(ss[k] * (1.0f / 1024.0f) + eps_);
            u32x2 o; o.x = pk2(v[k][i][0] * sc * gg[0], v[k][i][1] * sc * gg[1]); o.y = pk2(v[k][i][2] * sc * gg[2], v[k][i][3] * sc * gg[3]);
            *(u32x2*)(dst + (size_t)(row0 + k) * 1024 + 4 * lane + 256 * i) = o; } }
}
DEV void transpose_tile(const float* __restrict__ src, int R, int C, int r0, int c0, bf16_t* __restrict__ dst, float* tile, const float* __restrict__ rgain = nullptr) {
    const int tq = opq((int)threadIdx.x); const int tx = tq & 63, ty = tq >> 6;
    __syncthreads();
#pragma unroll
    for (int i = 0; i < 8; ++i) { const int rr = ty + 8 * i; tile[rr * 65 + tx] = src[(size_t)(r0 + rr) * C + c0 + tx] * (rgain ? rgain[r0 + rr] : 1.0f); }
    __syncthreads();
#pragma unroll
    for (int i = 0; i < 8; ++i) { const int cc = ty + 8 * i; dst[(size_t)(c0 + cc) * R + r0 + tx] = (bf16_t)(pk2(tile[tx * 65 + cc], 0.f) & 0xffffu); }
}
DEV void cvt_stream(const float* __restrict__ src, bf16_t* __restrict__ dst, size_t n4) {
    for (size_t i = (size_t)BID() * NT + opq((int)threadIdx.x); i < n4; i += (size_t)NBLK() * NT) {
        const f32x4 v = *(const f32x4*)(src + 4 * i); u32x2 o; o.x = pk2(v[0], v[1]); o.y = pk2(v[2], v[3]); *(u32x2*)(dst + 4 * i) = o; }
}


DEV unsigned pack_i8x4(float a, float b, float c, float d, float sc) {
    const unsigned q0 = __float_as_uint(fmaf(a, sc, 12582912.0f)), q1 = __float_as_uint(fmaf(b, sc, 12582912.0f)), q2 = __float_as_uint(fmaf(c, sc, 12582912.0f)), q3 = __float_as_uint(fmaf(d, sc, 12582912.0f));
    const unsigned p01 = __builtin_amdgcn_perm(q1, q0, 0x0c0c0400u), p23 = __builtin_amdgcn_perm(q3, q2, 0x0c0c0400u);
    return __builtin_amdgcn_perm(p23, p01, 0x05040100u);
}
DEV void cvt8_rows(const float* __restrict__ src, unsigned* __restrict__ dst8, float* __restrict__ scale, int lane, int wave, const float* __restrict__ cgain = nullptr, bool i8 = false) {
    for (int row0 = (BID() * 8 + wave) * 4; row0 < 16384; row0 += NBLK() * 32) {
        f32x4 v[4][4]; float am[4];
#pragma unroll
        for (int k = 0; k < 4; ++k)
#pragma unroll
            for (int i = 0; i < 4; ++i) { v[k][i] = *(const f32x4*)(src + (size_t)(row0 + k) * 1024 + 4 * lane + 256 * i); if (cgain) v[k][i] = v[k][i] * *(const f32x4*)(cgain + 4 * lane + 256 * i); }
#pragma unroll
        for (int k = 0; k < 4; ++k) { am[k] = 0.f;
#pragma unroll
            for (int i = 0; i < 4; ++i) am[k] = fmaxf(am[k], fmaxf(fmaxf(fabsf(v[k][i][0]), fabsf(v[k][i][1])), fmaxf(fabsf(v[k][i][2]), fabsf(v[k][i][3])))); }
#pragma unroll
        for (int o = 32; o; o >>= 1) {
#pragma unroll
            for (int k = 0; k < 4; ++k) am[k] = fmaxf(am[k], __shfl_xor(am[k], o)); }
#pragma unroll
        for (int k = 0; k < 4; ++k) { const float top = i8 ? 127.0f : 256.0f; const float sc = am[k] > 0.f ? top / am[k] : 1.0f;
#pragma unroll
            for (int i = 0; i < 4; ++i) { int pk;
                if (i8) pk = (int)pack_i8x4(v[k][i][0], v[k][i][1], v[k][i][2], v[k][i][3], sc);
                else { pk = __builtin_amdgcn_cvt_pk_fp8_f32(v[k][i][0] * sc, v[k][i][1] * sc, 0, false); pk = __builtin_amdgcn_cvt_pk_fp8_f32(v[k][i][2] * sc, v[k][i][3] * sc, pk, true); }
                dst8[((size_t)(2 * i + (lane >> 5)) * 16384 + row0 + k) * 32 + (lane & 31)] = (unsigned)pk; }
            if (lane == 0) scale[row0 + k] = am[k] > 0.f ? am[k] / top : 1.0f; }
    }
}

DEV void cv_finish(f32x4 (&cv)[2][4], unsigned* __restrict__ dst8, float* __restrict__ scale, const float* __restrict__ cgain, int row0, int lane, bool i8) {
#pragma unroll
    for (int k = 0; k < 2; ++k) {
        float am = 0.f;
#pragma unroll
        for (int i = 0; i < 4; ++i) { if (cgain) cv[k][i] = cv[k][i] * *(const f32x4*)(cgain + 4 * lane + 256 * i);
            am = fmaxf(am, fmaxf(fmaxf(fabsf(cv[k][i][0]), fabsf(cv[k][i][1])), fmaxf(fabsf(cv[k][i][2]), fabsf(cv[k][i][3])))); }
#pragma unroll
        for (int o = 32; o; o >>= 1) am = fmaxf(am, __shfl_xor(am, o));
        const float top = i8 ? 127.0f : 256.0f; const float sc = am > 0.f ? top / am : 1.0f;
#pragma unroll
        for (int i = 0; i < 4; ++i) { int pk;
            if (i8) pk = (int)pack_i8x4(cv[k][i][0], cv[k][i][1], cv[k][i][2], cv[k][i][3], sc);
            else { pk = __builtin_amdgcn_cvt_pk_fp8_f32(cv[k][i][0] * sc, cv[k][i][1] * sc, 0, false); pk = __builtin_amdgcn_cvt_pk_fp8_f32(cv[k][i][2] * sc, cv[k][i][3] * sc, pk, true); }
            dst8[((size_t)(2 * i + (lane >> 5)) * 16384 + row0 + k) * 32 + (lane & 31)] = (unsigned)pk; }
        if (lane == 0) scale[row0 + k] = am > 0.f ? am / top : 1.0f;
    }
}

DEV void phase0(CParams& p, unsigned char* smem) {
    const int tid = opq((int)threadIdx.x), lane = tid & 63, wave = tid >> 6, nb = NBLK(), bid = BID();
    unsigned char* ws = opqp(PWS);
    for (int row = (bid * 8 + wave) * 4; row < T_; row += nb * 32) rms_rows4(PIN(0), PIN(1), (bf16_t*)(ws + OFF_HN), row, lane);
    {
        const int tx = tid & 63, ty = tid >> 6;
        for (int i0 = bid; i0 < 2080; i0 += 4 * nb) {
            float tv[4][8];
            __syncthreads();
#pragma unroll
            for (int b = 0; b < 4; ++b) { const int i = i0 + b * nb;
                if (i < 2080) {
                    const float* src; int R, C, ti; const float* rg = nullptr;
                    if (i < 1024) { src = PIN(2); R = 1024; C = 4096; ti = i; }
                    else if (i < 1536) { src = PIN(16); R = 1024; C = 2048; ti = i - 1024; rg = PIN(15); }
                    else if (i < 1792) { src = PIN(14); R = 1024; C = 1024; ti = i - 1536; }
                    else if (i < 1920) { src = PIN(12); R = 512; C = 1024; ti = i - 1792; }
                    else if (i < 2048) { src = PIN(13); R = 512; C = 1024; ti = i - 1920; }
                    else { src = PIN(10); R = 64; C = 2048; ti = i - 2048; }
                    const int tc = C / 64, r0 = (ti / tc) * 64, c0 = (ti % tc) * 64;
#pragma unroll
                    for (int k = 0; k < 8; ++k) { const int rr = ty + 8 * k; tv[b][k] = src[(size_t)(r0 + rr) * C + c0 + tx] * (rg ? rg[r0 + rr] : 1.0f); }
                } }
#pragma unroll
            for (int b = 0; b < 4; ++b) { float* tile = (float*)smem + b * (64 * 65);
                if (i0 + b * nb < 2080) {
#pragma unroll
                    for (int k = 0; k < 8; ++k) tile[(ty + 8 * k) * 65 + tx] = tv[b][k]; } }
            __syncthreads();
#pragma unroll
            for (int b = 0; b < 4; ++b) { const int i = i0 + b * nb;
                if (i < 2080) {
                    bf16_t* dst; int R, C, ti;
                    if (i < 1024) { dst = (bf16_t*)(ws + OFF_WIN); R = 1024; C = 4096; ti = i; }
                    else if (i < 1536) { dst = (bf16_t*)(ws + OFF_WQ); R = 1024; C = 2048; ti = i - 1024; }
                    else if (i < 1792) { dst = (bf16_t*)(ws + OFF_WOUT); R = 1024; C = 1024; ti = i - 1536; }
                    else if (i < 1920) { dst = (bf16_t*)(ws + OFF_WHY); R = 512; C = 1024; ti = i - 1792; }
                    else if (i < 2048) { dst = (bf16_t*)(ws + OFF_WFN); R = 512; C = 1024; ti = i - 1920; }
                    else { dst = (bf16_t*)(ws + OFF_W3); R = 64; C = 2048; ti = i - 2048; }
                    const int tc = C / 64, r0 = (ti / tc) * 64, c0 = (ti % tc) * 64;
                    const float* tile = (const float*)smem + b * (64 * 65);
#pragma unroll
                    for (int k = 0; k < 8; ++k) { const int cc = ty + 8 * k; dst[(size_t)(c0 + cc) * R + r0 + tx] = (bf16_t)(pk2(tile[tx * 65 + cc], 0.f) & 0xffffu); }
                } }
        }
        __syncthreads();
    }
    for (int i = bid * NT + tid; i < T_; i += nb * NT) ((unsigned long long*)(ws + OFF_SS1))[i] = 0ull;
    cvt_stream(PIN(17), (bf16_t*)(ws + OFF_KEYS), 262144 / 4);
    if (NBLK() != 256) cvt8_rows(PIN(18), (unsigned*)(ws + OFF_U), (float*)(ws + OFF_US), lane, wave, PIN(15), true);
    {
        const float* w1 = PIN(6); const float* b1 = PIN(7); const float* w2 = PIN(8); const float* b2 = PIN(9);
        bf16_t* hd = (bf16_t*)(ws + OFF_HDN2);
        float w1c[33], w2c[64];
#pragma unroll
        for (int i = 0; i < 33; ++i) w1c[i] = w1[i * 64 + lane];
#pragma unroll
        for (int i = 0; i < 64; ++i) w2c[i] = w2[i * 64 + lane];
        const float b1v = b1[lane], b2v = b2[lane];
        const float b0_ = __int_as_float(opq(__float_as_int(1e-4f)));
        const int lstep = nb * 8;
        for (int l = bid * 8 + wave; l < L_; l += lstep) {
            const float tpos = (float)l / 8191.0f, rev = (float)l * (1.0f / 8192.0f);
            float z = 0.f;
            if (lane == 0) z = tpos;
            if (lane >= 1 && lane <= 16) { const float band = b0_ + (float)(lane - 1) * ((15.0f - 1e-4f) / 15.0f); z = __builtin_amdgcn_cosf(__builtin_amdgcn_fractf(band * rev)); }
            else if (lane >= 17 && lane <= 32) { const float band = b0_ + (float)(lane - 17) * ((15.0f - 1e-4f) / 15.0f); z = -__builtin_amdgcn_sinf(__builtin_amdgcn_fractf(band * rev)); }
            float a = b1v;
#pragma unroll
            for (int i = 0; i < 33; ++i) a += __shfl(z, i) * w1c[i];
            const float h1 = __builtin_amdgcn_sinf(__builtin_amdgcn_fractf(a * 0.15915494309189535f));
            float c = b2v;
#pragma unroll
            for (int i = 0; i < 64; ++i) c += __shfl(h1, i) * w2c[i];
            const float h2 = __builtin_amdgcn_sinf(__builtin_amdgcn_fractf(c * 0.15915494309189535f));
            hd[l * 64 + lane] = (bf16_t)(pk2(h2, 0.f) & 0xffffu);
        }
    }
    {
        bf16_t* dt = (bf16_t*)(ws + OFF_DT);
        unsigned char* tab = ws + OFF_TAB;
        for (int i = bid * NT + tid; i < 32768; i += nb * NT) {
            const int row = i >> 7, j = i & 127, c = row & 127, plane = row >> 7;
            const float x = (float)((c * j) & 127) * (1.0f / 64.0f);
            const float cv = cospif(x), sv = sinpif(x);
            dt[i] = (bf16_t)(pk2((plane ? sv : cv) * (1.0f / 1024.0f), 0.f) & 0xffffu);
            const int r128 = c, k = j;
            const int off = img_off(r128, k >> 3, 128) + (k & 7) * 2;
            *(bf16_t*)(tab + plane * 32768 + off) = (bf16_t)(pk2(plane ? sv : cv, 0.f) & 0xffffu);
        }
    }
}

DEV void phase1(CParams& p, unsigned char* smem) {
    const int tid = opq((int)threadIdx.x); const int lane = tid & 63, w = tid >> 6, r = lane & 15, q = lane >> 4, wm = w >> 1, wn = w & 1;
    unsigned char* ws = opqp(PWS);
    const bf16_t* hn = (const bf16_t*)(ws + OFF_HN);
    const bf16_t* w_in_t = (const bf16_t*)(ws + OFF_WIN);
    const float* b_in = PIN(3);
    {
        bf16_t* pT = (bf16_t*)(ws + OFF_PT);
        auto f = [=](int row, int col0, f32x4 v0, f32x4 v1) { const float bias = b_in[row];
            *(u32x4*)(pT + (size_t)row * T_ + col0) = pack8v(v0 + bias, v1 + bias); };
        run_gemm(smem, w_in_t, hn, 2048, T_, 1024, f);
    }
    {
        bf16_t* sg = (bf16_t*)POUT;
        auto f = [=](int row, int col0, f32x4 v0, f32x4 v1) { const f32x4 b0 = *(const f32x4*)(b_in + 2048 + col0), b1 = *(const f32x4*)(b_in + 2048 + col0 + 4);
            f32x4 a = v0 + b0, b = v1 + b1;
#pragma unroll
            for (int k = 0; k < 4; ++k) { a[k] = sigmoidf_(a[k]); b[k] = sigmoidf_(b[k]); }
            *(u32x4*)(sg + (size_t)row * 2048 + col0) = pack8v(a, b); };
        run_gemm(smem, hn, w_in_t + (size_t)2048 * 1024, T_, 2048, 1024, f);
    }
    for (int i = BID() + 2048; i < 2592; i += NBLK()) {
        f32x4 acc[4][4];
        if (i < 2560) {
            const int i3 = i - 2048, tm = i3 >> 4, tn = i3 & 15;
            RowLoader<256> la{(const bf16_t*)(ws + OFF_HDN2) + (size_t)tm * 256 * 64, 64, tid}; RowLoader<128> lb{(const bf16_t*)(ws + OFF_W3) + (size_t)tn * 128 * 64, 64, tid};
            gemm_core(la, lb, 1, smem, acc);
            bf16_t* hf = (bf16_t*)(ws + OFF_HF);
            const float min_decay = -3.0701134573253946f, max_decay = -15.350567286626973f;
#pragma unroll
            for (int ni = 0; ni < 4; ++ni) { const int col = 128 * tn + 64 * wn + 16 * ni + r, c = col & 511;
                const float delta = fabsf(min_decay + (float)c * ((max_decay - min_decay) / 511.0f));
#pragma unroll
                for (int mi = 0; mi < 4; ++mi) { const int l = 256 * tm + 64 * wm + 16 * mi + 4 * q; const f32x4 v = acc[mi][ni];
                    float e[4];
#pragma unroll
                    for (int k = 0; k < 4; ++k) e[k] = v[k] * __expf(-((float)(l + k) * (1.0f / 8191.0f)) * delta);
                    u32x2 o; o.x = pk2(e[0], e[1]); o.y = pk2(e[2], e[3]);
                    *(u32x2*)(hf + (size_t)col * L_ + l) = o; } }
        } else {
            const int i4 = i - 2560, g = i4 >> 3, tn = i4 & 7;
            RowLoader<256> la{(const bf16_t*)(ws + OFF_DT), 128, tid}; RowLoader<128> lb{(const bf16_t*)(ws + OFF_WFN) + (size_t)tn * 128 * 512 + g * 128, 512, tid};
            gemm_core(la, lb, 2, smem, acc);
            bf16_t* w2 = (bf16_t*)(ws + OFF_W2);
#pragma unroll
            for (int ni = 0; ni < 4; ++ni) { const int n = 128 * tn + 64 * wn + 16 * ni + r;
#pragma unroll
                for (int mi = 0; mi < 4; ++mi) { const int mm = 64 * wm + 16 * mi + 4 * q, plane = mm >> 7, c = mm & 127; const f32x4 v = acc[mi][ni];
                    u32x2 o; o.x = pk2(v[0], v[1]); o.y = pk2(v[2], v[3]);
                    *(u32x2*)(w2 + (size_t)n * 1024 + plane * 512 + g * 128 + c) = o; } }
        }
    }
}

template <int MI, int NI, int KS, bool REAL_IN, bool INV, bool VN>
DEV void cstep(const unsigned char* inR, const unsigned char* inI, int in_rows, int row0, const unsigned char* tabC, const unsigned char* tabS, int tmul, int col0,
               f32x4 (&aR)[MI][NI], f32x4 (&aI)[MI][NI], int lane) {
    lane = opq(lane);
    const int r = lane & 15, q = lane >> 4;
#pragma unroll
    for (int mi = 0; mi < MI; ++mi)
#pragma unroll
        for (int ni = 0; ni < NI; ++ni) { aR[mi][ni] = (f32x4){0.f, 0.f, 0.f, 0.f}; aI[mi][ni] = (f32x4){0.f, 0.f, 0.f, 0.f}; }
    const int toff = (q * 128 + col0 * tmul + ((r * tmul) ^ q)) << 4;
    const int doff = (q * in_rows + row0 + (r ^ q)) << 4;
#pragma unroll 1
    for (int s = 0; s < KS; ++s) {
        bf16x8 fc[NI], fs[NI], fn[NI];
#pragma unroll
        for (int ni = 0; ni < NI; ++ni) { const int o = toff + ((4 * s * 128 + 16 * ni * tmul) << 4);
            fc[ni] = *(const bf16x8*)(tabC + o); fs[ni] = *(const bf16x8*)(tabS + o); fn[ni] = neg8(fs[ni]); }
#pragma unroll
        for (int mi = 0; mi < MI; ++mi) {
            const int o = doff + ((4 * s * in_rows + 16 * mi) << 4);
            const bf16x8 ar = *(const bf16x8*)(inR + o);
            bf16x8 ai = ar;
            if (!REAL_IN) ai = *(const bf16x8*)(inI + o);
#pragma unroll
            for (int ni = 0; ni < NI; ++ni) {
                const bf16x8 sR = INV ? fn[ni] : fs[ni], sI = INV ? fs[ni] : fn[ni];
                if (VN) {
                    aR[mi][ni] = mfma16(fc[ni], ar, aR[mi][ni]); aI[mi][ni] = mfma16(sI, ar, aI[mi][ni]);
                    if (!REAL_IN) { aR[mi][ni] = mfma16(sR, ai, aR[mi][ni]); aI[mi][ni] = mfma16(fc[ni], ai, aI[mi][ni]); }
                } else {
                    aR[mi][ni] = mfma16(ar, fc[ni], aR[mi][ni]); aI[mi][ni] = mfma16(ar, sI, aI[mi][ni]);
                    if (!REAL_IN) { aR[mi][ni] = mfma16(ai, sR, aR[mi][ni]); aI[mi][ni] = mfma16(ai, fc[ni], aI[mi][ni]); }
                }
            }
        }
    }
}
DEV void st4(unsigned char* img, int row, int k, int rows, float a, float b, float c, float d) {
    u32x2 o; o.x = pk2(a, b); o.y = pk2(c, d); *(u32x2*)(img + img_off(row, k >> 3, rows) + (k & 7) * 2) = o;
}
DEV u32x4 pack8(const float* v) { u32x4 o; o.x = pk2(v[0], v[1]); o.y = pk2(v[2], v[3]); o.z = pk2(v[4], v[5]); o.w = pk2(v[6], v[7]); return o; }

DEV void hyena_task(CParams& p, int c, int tk, unsigned char* smem) {
    const int tid = opq((int)threadIdx.x), lane = tid & 63, w = tid >> 6; int r, q;
    unsigned char* ws = opqp(PWS);
    const unsigned char* tabC = smem; const unsigned char* tabS = smem + 32768;
    unsigned char* dR = smem + 65536; unsigned char* dI = smem + 98304;
    float* red = (float*)(smem + 131072);
    const int row0 = 64 * (w >> 2), col0 = 32 * (w & 3), col0h = 16 * (w & 3);
    unsigned* kf = (unsigned*)(ws + OFF_HN) + (size_t)BID() * 32768;
    const bf16_t* hfT = (const bf16_t*)(ws + OFF_HF);
    const bf16_t* pT = (const bf16_t*)(ws + OFF_PT);
    bf16_t* zT = (bf16_t*)(ws + OFF_ZHY) + (size_t)c * T_;
    const float* cw = PIN(4); const float* cbv = PIN(5); const float* skip = PIN(11);
    const float inv16384 = 1.0f / 16384.0f;

    const bf16_t* pv = pT + (size_t)c * T_; const bf16_t* px1 = pT + (size_t)(512 + c) * T_; const bf16_t* px2 = pT + (size_t)(1024 + c) * T_;
    u32x4 pf[4];
#define PF_LOAD(ROWA, ROWB) { _Pragma("unroll") for (int i = 0; i < 4; ++i) { const int ch = tid + i * NT; pf[i] = *(const u32x4*)(ch < 1024 ? (ROWA) + ch * 8 : (ROWB) + (ch - 1024) * 8); } }
    PF_LOAD(hfT + (size_t)(0 * 512 + c) * L_, hfT + (size_t)(1 * 512 + c) * L_);
    {
        unsigned char* xraw = smem + 135168;
        float part0 = 0.f, part1 = 0.f;
#define KF_BUILD(DST, RAWF, RAWB, HALF, PART) { const int u = tid + (HALF) * NT; const int mp = u & 63, kc = u >> 6; unsigned e0[8], e1[8]; \
            _Pragma("unroll") for (int j = 0; j < 8; ++j) { const int n1 = 8 * kc + j, n = 128 * n1 + 2 * mp; \
                if ((HALF) == 0) { const unsigned d = *(const unsigned*)((RAWF) + n); e0[j] = d & 0xffffu; e1[j] = d >> 16; } \
                else { const unsigned v0 = (unsigned)(RAWB)[min(16384 - n, 8191)]; e0[j] = (n == 8192) ? 0u : v0; e1[j] = (unsigned)(RAWB)[16383 - n]; } \
                PART += fabsf(__uint_as_float(e0[j] << 16)) + fabsf(__uint_as_float(e1[j] << 16)); } \
            u32x4 lo, hi; \
            lo.x = e0[0] | (e0[1] << 16); lo.y = e0[2] | (e0[3] << 16); lo.z = e0[4] | (e0[5] << 16); lo.w = e0[6] | (e0[7] << 16); \
            hi.x = e1[0] | (e1[1] << 16); hi.y = e1[2] | (e1[3] << 16); hi.z = e1[4] | (e1[5] << 16); hi.w = e1[6] | (e1[7] << 16); \
            *(u32x4*)((DST) + img_off(2 * mp, kc, 128)) = lo; *(u32x4*)((DST) + img_off(2 * mp + 1, kc, 128)) = hi; }
        lds_barrier();
#pragma unroll
        for (int i = 0; i < 4; ++i) { const int ch = tid + i * NT; *(u32x4*)(dI + ch * 16) = pf[i]; }
        PF_LOAD(hfT + (size_t)(2 * 512 + c) * L_, hfT + (size_t)(3 * 512 + c) * L_);
        lds_barrier();
        { const bf16_t* raw = (const bf16_t*)dI; KF_BUILD(dR, raw, raw + 8192, 0, part0); KF_BUILD(dR, raw, raw + 8192, 1, part0); }
        lds_barrier();
#pragma unroll
        for (int i = 0; i < 4; ++i) { const int ch = tid + i * NT; *(u32x4*)((ch < 1024 ? dI + 16384 : xraw - 16384) + ch * 16) = pf[i]; }
        PF_LOAD(pv, pv + L_);
        lds_barrier();
        { const bf16_t* rawf = (const bf16_t*)(dI + 16384); const bf16_t* rawb = (const bf16_t*)xraw; KF_BUILD(dI, rawf, rawb, 0, part1); lds_barrier(); KF_BUILD(dI, rawf, rawb, 1, part1); }
#undef KF_BUILD
        part0 = wave_sum(part0); part1 = wave_sum(part1);
        if (lane == 0) { red[w] = part0; red[8 + w] = part1; }
        lds_barrier();
        float S0 = 0.f, S1 = 0.f;
#pragma unroll
        for (int i = 0; i < 8; ++i) { S0 += red[i]; S1 += red[8 + i]; }
        const float h0 = 0.5f * inv16384 / S0, h1 = 0.5f * inv16384 / S1;
        f32x4 aR[4][2], aI[4][2];
        cstep<4, 2, 4, false, false, false>(dR, dI, 128, row0, tabC, tabS, 1, col0, aR, aI, lane);
        lds_barrier();
        RQ
#pragma unroll
        for (int mi = 0; mi < 4; ++mi)
#pragma unroll
            for (int ni = 0; ni < 2; ++ni) { const int k1 = col0 + 16 * ni + r, n2 = row0 + 16 * mi + 4 * q; float orr[4], oi[4];
#pragma unroll
                for (int i = 0; i < 4; ++i) { const float ang = (float)((n2 + i) * k1) * inv16384; const float cs = __builtin_amdgcn_cosf(ang), sn = __builtin_amdgcn_sinf(ang);
                    const float xr = aR[mi][ni][i], xi = aI[mi][ni][i]; orr[i] = xr * cs + xi * sn; oi[i] = xi * cs - xr * sn; }
                st4(dR, k1, n2, 128, orr[0], orr[1], orr[2], orr[3]); st4(dI, k1, n2, 128, oi[0], oi[1], oi[2], oi[3]); __builtin_amdgcn_sched_barrier(0); }
        lds_barrier();
        cstep<4, 2, 4, false, false, true>(dR, dI, 128, row0, tabC, tabS, 1, col0, aR, aI, lane);
        lds_barrier();
        RQ
#pragma unroll
        for (int mi = 0; mi < 4; ++mi)
#pragma unroll
            for (int ni = 0; ni < 2; ++ni) { const int k1 = row0 + 16 * mi + r, k2 = col0 + 16 * ni + 4 * q; u32x2 vr, vi;
                vr.x = pk2(aR[mi][ni][0], aR[mi][ni][1]); vr.y = pk2(aR[mi][ni][2], aR[mi][ni][3]); vi.x = pk2(aI[mi][ni][0], aI[mi][ni][1]); vi.y = pk2(aI[mi][ni][2], aI[mi][ni][3]);
                *(u32x2*)(dR + (k1 * 128 + k2) * 2) = vr; *(u32x2*)(dI + (k1 * 128 + k2) * 2) = vi; }
        lds_barrier();
#pragma unroll 2
        for (int it = 0; it < 8; ++it) { const int qd = tid + it * NT, k1 = qd >> 5, k2 = (qd & 31) << 2, k1m = (128 - k1) & 127;
            const u32x2 ar_ = *(const u32x2*)(dR + (k1 * 128 + k2) * 2), ai_ = *(const u32x2*)(dI + (k1 * 128 + k2) * 2);
            const u32x2 mr_ = *(const u32x2*)(dR + (k1m * 128 + 124 - k2) * 2), mi_ = *(const u32x2*)(dI + (k1m * 128 + 124 - k2) * 2);
            const int ks = (128 - k2) & 127;
            const float sr = bf2f(((const bf16_t*)dR)[ks]), si = bf2f(((const bf16_t*)dI)[ks]);
            const float a_r[4] = {bf_lo(ar_.x), bf_hi(ar_.x), bf_lo(ar_.y), bf_hi(ar_.y)}, a_i[4] = {bf_lo(ai_.x), bf_hi(ai_.x), bf_lo(ai_.y), bf_hi(ai_.y)};
            const float e_r[4] = {bf_lo(mr_.x), bf_hi(mr_.x), bf_lo(mr_.y), bf_hi(mr_.y)}, e_i[4] = {bf_lo(mi_.x), bf_hi(mi_.x), bf_lo(mi_.y), bf_hi(mi_.y)};
            u32x4 o0, o1;
#pragma unroll
            for (int j = 0; j < 4; ++j) { const float mr = k1 ? e_r[3 - j] : (j == 0 ? sr : e_r[(4 - j) & 3]), mi2 = k1 ? e_i[3 - j] : (j == 0 ? si : e_i[(4 - j) & 3]);
                o0[j] = pk2((a_r[j] + mr) * h0, (a_i[j] - mi2) * h0); o1[j] = pk2((a_i[j] + mi2) * h1, (mr - a_r[j]) * h1); }
            *(u32x4*)(kf + k1 * 128 + k2) = o0; *(u32x4*)(kf + 16384 + k1 * 128 + k2) = o1; }
    }
    const float wv0 = cw[c], wv1 = cw[1536 + c], wv2 = cw[3072 + c], cv = cbv[c];
    const float wa0 = cw[512 + c], wa1 = cw[1536 + 512 + c], wa2 = cw[3072 + 512 + c], ca = cbv[512 + c];
    const float wb0 = cw[1024 + c], wb1 = cw[1536 + 1024 + c], wb2 = cw[3072 + 1024 + c], cb = cbv[1024 + c];
    const float sk0 = skip[c], sk1 = skip[512 + c];
    lds_barrier();
    bf16_t* usc = (bf16_t*)(ws + OFF_USC) + (size_t)BID() * (3 * 2 * 128 * 64);
    {
        const int mp = tid & 63, kc = tid >> 6;
#pragma unroll
        for (int sig = 0; sig < 3; ++sig) {
            const float w0 = sig == 0 ? wv0 : sig == 1 ? wa0 : wb0, w1 = sig == 0 ? wv1 : sig == 1 ? wa1 : wb1, w2 = sig == 0 ? wv2 : sig == 1 ? wa2 : wb2, cc = sig == 0 ? cv : sig == 1 ? ca : cb;
            const bf16_t* ps = sig == 0 ? pv : sig == 1 ? px1 : px2;
            if (sig) lds_barrier();
#pragma unroll
            for (int i = 0; i < 4; ++i) { const int ch = tid + i * NT, b = ch >> 10, cidx = ch & 1023;
                *(u32x4*)((b ? dI : dR) + 16384 + cidx * 16) = pf[i]; }
            if (sig < 2) { const bf16_t* nx = sig == 0 ? px1 : px2; PF_LOAD(nx, nx + L_); }
            lds_barrier();
#pragma unroll
            for (int b = 0; b < 2; ++b) {
                const bf16_t* pr = (const bf16_t*)((b ? dI : dR) + 16384);
                float u0[8], u1[8];
#pragma unroll
                for (int j = 0; j < 8; ++j) { const int l = 128 * (8 * kc + j) + 2 * mp;
                    const float pmv = bf2f(pr[max(l - 1, 0)]); const unsigned d = *(const unsigned*)(pr + l); const float p0 = bf_lo(d), p1 = bf_hi(d);
                    const float ppv = bf2f(pr[min(l + 2, L_ - 1)]);
                    const float pm = l > 0 ? pmv : 0.f, pp = (l + 2 < L_) ? ppv : 0.f;
                    u0[j] = w0 * pm + w1 * p0 + w2 * p1 + cc; u1[j] = w0 * p0 + w1 * p1 + w2 * pp + cc; }
                const u32x4 lo = pack8(u0), hi = pack8(u1);
                if (sig == 0) { unsigned char* dst = b ? dI : dR; *(u32x4*)(dst + img_off(2 * mp, kc, 128)) = lo; *(u32x4*)(dst + img_off(2 * mp + 1, kc, 128)) = hi; }
                bf16_t* ud = usc + ((size_t)(sig * 2 + b) * 128 + 2 * mp) * 64 + 8 * kc;
                *(u32x4*)ud = lo; *(u32x4*)(ud + 64) = hi;
            }
        }
    }
    lds_barrier();
    float z1r[4][4], z1i[4][4];
#pragma unroll
    for (int o = 0; o < 2; ++o) {
        f32x4 aR[4][2], aI[4][2];
        const int nblk_ = NBLK(), bid_ = BID(); const bool bgj = nblk_ == 256;
        const float* cv_src = o == 0 ? PIN(18) : PIN(19); unsigned* cv_dst = (unsigned*)(ws + (o == 0 ? OFF_U : OFF_V)); float* cv_sc = (float*)(ws + (o == 0 ? OFF_US : OFF_VS)); const float* cv_gain = o == 0 ? PIN(15) : nullptr;
        f32x4 cv[2][4];
#define CV_ISSUE(PT) if (bgj) { const int row0_ = 2 * ((((tk * 2 + (PT)) * 256 + bid_) * 8) + (tid >> 6)); _Pragma("unroll") for (int k = 0; k < 2; ++k) _Pragma("unroll") for (int i = 0; i < 4; ++i) cv[k][i] = *(const f32x4*)(cv_src + (size_t)(row0_ + k) * 1024 + 4 * lane + 256 * i); }
#define CV_FINISH(PT) if (bgj) { const int row0_ = 2 * ((((tk * 2 + (PT)) * 256 + bid_) * 8) + (tid >> 6)); cv_finish(cv, cv_dst, cv_sc, cv_gain, row0_, lane, true); }
        CV_ISSUE(0)
        cstep<4, 2, 2, false, false, false>(dR, dI, 128, row0, tabC, tabS, 1, col0, aR, aI, lane);
        lds_barrier();
        RQ
#pragma unroll
        for (int mi = 0; mi < 4; ++mi)
#pragma unroll
            for (int ni = 0; ni < 2; ++ni) { const int k1 = col0 + 16 * ni + r, n2 = row0 + 16 * mi + 4 * q; float orr[4], oi[4];
#pragma unroll
                for (int i = 0; i < 4; ++i) { const float ang = (float)((n2 + i) * k1) * inv16384; const float cs = __builtin_amdgcn_cosf(ang), sn = __builtin_amdgcn_sinf(ang);
                    const float xr = aR[mi][ni][i], xi = aI[mi][ni][i]; orr[i] = xr * cs + xi * sn; oi[i] = xi * cs - xr * sn; }
                st4(dR, k1, n2, 128, orr[0], orr[1], orr[2], orr[3]); st4(dI, k1, n2, 128, oi[0], oi[1], oi[2], oi[3]); __builtin_amdgcn_sched_barrier(0); }
        CV_FINISH(0)
        lds_barrier();
        u32x4 kfr[4][2];
        RQ
#pragma unroll
        for (int mi = 0; mi < 4; ++mi)
#pragma unroll
            for (int ni = 0; ni < 2; ++ni) kfr[mi][ni] = *(const u32x4*)(kf + o * 16384 + (row0 + 16 * mi + r) * 128 + col0 + 16 * ni + 4 * q);
        cstep<4, 2, 4, false, false, true>(dR, dI, 128, row0, tabC, tabS, 1, col0, aR, aI, lane);
        lds_barrier();
        RQ
#pragma unroll
        for (int mi = 0; mi < 4; ++mi)
#pragma unroll
            for (int ni = 0; ni < 2; ++ni) { const int k1 = row0 + 16 * mi + r, k2 = col0 + 16 * ni + 4 * q; float orr[4], oi[4];
                const u32x4 kk = kfr[mi][ni];
#pragma unroll
                for (int i = 0; i < 4; ++i) { const float kr = bf_lo(kk[i]), ki = bf_hi(kk[i]); const float xr = aR[mi][ni][i], xi = aI[mi][ni][i];
                    orr[i] = xr * kr - xi * ki; oi[i] = xr * ki + xi * kr; }
                st4(dR, k1, k2, 128, orr[0], orr[1], orr[2], orr[3]); st4(dI, k1, k2, 128, oi[0], oi[1], oi[2], oi[3]); __builtin_amdgcn_sched_barrier(0); }
        lds_barrier();
        CV_ISSUE(1)
        cstep<4, 2, 4, false, true, false>(dR, dI, 128, row0, tabC, tabS, 1, col0, aR, aI, lane);
        lds_barrier();
        RQ
#pragma unroll
        for (int mi = 0; mi < 4; ++mi)
#pragma unroll
            for (int ni = 0; ni < 2; ++ni) { const int n2 = col0 + 16 * ni + r, k1 = row0 + 16 * mi + 4 * q; float orr[4], oi[4];
#pragma unroll
                for (int i = 0; i < 4; ++i) { const float ang = (float)(n2 * (k1 + i)) * inv16384; const float cs = __builtin_amdgcn_cosf(ang), sn = __builtin_amdgcn_sinf(ang);
                    const float xr = aR[mi][ni][i], xi = aI[mi][ni][i]; orr[i] = xr * cs - xi * sn; oi[i] = xr * sn + xi * cs; }
                st4(dR, n2, k1, 128, orr[0], orr[1], orr[2], orr[3]); st4(dI, n2, k1, 128, oi[0], oi[1], oi[2], oi[3]); __builtin_amdgcn_sched_barrier(0); }
        CV_FINISH(1)
        __syncthreads();
        u32x2 pre[4][4];
        RQ
#pragma unroll
        for (int mi = 0; mi < 4; ++mi) { const bf16_t* ub = usc + (size_t)(row0 + 16 * mi + r) * 64 + col0h + 4 * q;
            if (o == 0) { pre[mi][0] = *(const u32x2*)(ub); pre[mi][1] = *(const u32x2*)(ub + 8192); pre[mi][2] = *(const u32x2*)(ub + 2 * 8192); pre[mi][3] = *(const u32x2*)(ub + 3 * 8192); }
            else { pre[mi][0] = *(const u32x2*)(ub + 4 * 8192); pre[mi][1] = *(const u32x2*)(ub + 5 * 8192); } }
        f32x4 yR[4][1], yI[4][1];
        cstep<4, 1, 4, false, true, true>(dR, dI, 128, row0, tabC, tabS, 1, col0h, yR, yI, lane);
        lds_barrier();
        RQ
#pragma unroll
        for (int mi = 0; mi < 4; ++mi) { const int n2 = row0 + 16 * mi + r, n1 = col0h + 4 * q;
            if (o == 0) {
                const u32x2 v0 = pre[mi][0], v1 = pre[mi][1], a0 = pre[mi][2], a1 = pre[mi][3];
                const float vv0[4] = {bf_lo(v0.x), bf_hi(v0.x), bf_lo(v0.y), bf_hi(v0.y)}, vv1[4] = {bf_lo(v1.x), bf_hi(v1.x), bf_lo(v1.y), bf_hi(v1.y)};
                const float aa0[4] = {bf_lo(a0.x), bf_hi(a0.x), bf_lo(a0.y), bf_hi(a0.y)}, aa1[4] = {bf_lo(a1.x), bf_hi(a1.x), bf_lo(a1.y), bf_hi(a1.y)};
#pragma unroll
                for (int i = 0; i < 4; ++i) { z1r[mi][i] = aa0[i] * (yR[mi][0][i] + sk0 * vv0[i]); z1i[mi][i] = aa1[i] * (yI[mi][0][i] + sk0 * vv1[i]); }
                st4(dR, n2, n1, 128, z1r[mi][0], z1r[mi][1], z1r[mi][2], z1r[mi][3]); st4(dI, n2, n1, 128, z1i[mi][0], z1i[mi][1], z1i[mi][2], z1i[mi][3]);
            } else {
                const u32x2 b0 = pre[mi][0], b1 = pre[mi][1];
                const float bb0[4] = {bf_lo(b0.x), bf_hi(b0.x), bf_lo(b0.y), bf_hi(b0.y)}, bb1[4] = {bf_lo(b1.x), bf_hi(b1.x), bf_lo(b1.y), bf_hi(b1.y)};
#pragma unroll
                for (int i = 0; i < 4; ++i) { const int l = 128 * (n1 + i) + n2;
                    const float zr = bb0[i] * (yR[mi][0][i] + sk1 * z1r[mi][i]);
                    const float zi = bb1[i] * (yI[mi][0][i] + sk1 * z1i[mi][i]);
                    ((bf16_t*)dR)[l] = (bf16_t)(pk2(zr, 0.f) & 0xffffu); ((bf16_t*)dI)[l] = (bf16_t)(pk2(zi, 0.f) & 0xffffu); }
            }
        }
        lds_barrier();
        if (o == 1) {
#pragma unroll
            for (int i = 0; i < 4; ++i) { const int ch = tid + i * NT, b = ch >> 10, cidx = ch & 1023;
                *(u32x4*)(zT + b * L_ + cidx * 8) = *(const u32x4*)((b ? dI : dR) + cidx * 16); }
        }
    }
}

DEV void fnet_task(CParams& p, int ch, unsigned char* smem) {
    const int tid = opq((int)threadIdx.x), lane = tid & 63, w = tid >> 6; int r, q;
    unsigned char* ws = opqp(PWS);
    const unsigned char* tabC = smem; const unsigned char* tabS = smem + 32768;
    unsigned char* d0 = smem + 65536; unsigned char* d1 = smem + 98304;
    const bf16_t* src = (const bf16_t*)(ws + OFF_PT) + (size_t)(1536 + ch) * T_;
    bf16_t* PT = (bf16_t*)(ws + OFF_PRI);
    lds_barrier();
    for (int u = tid; u < 1024; u += NT) {
        const int mp = u & 63, b = (u >> 6) & 1, kc = u >> 7;
        unsigned d[8];
#pragma unroll
        for (int j = 0; j < 8; ++j) d[j] = *(const unsigned*)(src + b * L_ + 128 * (8 * kc + j) + 2 * mp);
        u32x4 lo, hi;
        lo.x = (d[0] & 0xffffu) | (d[1] << 16); lo.y = (d[2] & 0xffffu) | (d[3] << 16); lo.z = (d[4] & 0xffffu) | (d[5] << 16); lo.w = (d[6] & 0xffffu) | (d[7] << 16);
        hi.x = (d[0] >> 16) | (d[1] & 0xffff0000u); hi.y = (d[2] >> 16) | (d[3] & 0xffff0000u); hi.z = (d[4] >> 16) | (d[5] & 0xffff0000u); hi.w = (d[6] >> 16) | (d[7] & 0xffff0000u);
        *(u32x4*)(d0 + img_off(b * 128 + 2 * mp, kc, 256)) = lo; *(u32x4*)(d0 + img_off(b * 128 + 2 * mp + 1, kc, 256)) = hi;
    }
    lds_barrier();
    f32x4 aR[4][2], aI[4][2];
    {
        const int row0 = 64 * (w >> 1), col0 = 32 * (w & 1);
        cstep<4, 2, 2, true, false, false>(d0, d0, 256, row0, tabC, tabS, 2, col0, aR, aI, lane);
        lds_barrier();
        RQ
#pragma unroll
        for (int mi = 0; mi < 4; ++mi)
#pragma unroll
            for (int ni = 0; ni < 2; ++ni) { const int k1 = col0 + 16 * ni + r, rows = row0 + 16 * mi + 4 * q, n2 = rows & 127; float orr[4], oi[4];
#pragma unroll
                for (int i = 0; i < 4; ++i) { const float ang = (float)((n2 + i) * k1) * (1.0f / 8192.0f); const float cs = __builtin_amdgcn_cosf(ang), sn = __builtin_amdgcn_sinf(ang);
                    const float xr = aR[mi][ni][i], xi = aI[mi][ni][i]; orr[i] = xr * cs + xi * sn; oi[i] = xi * cs - xr * sn; }
                st4(d0, k1, rows, 64, orr[0], orr[1], orr[2], orr[3]); st4(d1, k1, rows, 64, oi[0], oi[1], oi[2], oi[3]); __builtin_amdgcn_sched_barrier(0); }
        lds_barrier();
    }
    {
        const int b = w >> 2, col0 = 32 * (w & 3);
        cstep<4, 2, 4, false, false, false>(d0 + b * 16384, d1 + b * 16384, 64, 0, tabC, tabS, 1, col0, aR, aI, lane);
        RQ
#pragma unroll
        for (int mi = 0; mi < 4; ++mi)
#pragma unroll
            for (int ni = 0; ni < 2; ++ni) { const int k2 = col0 + 16 * ni + r, k1 = 16 * mi + 4 * q; const size_t o = (size_t)ch * T_ + b * L_ + 64 * k2 + k1;
                u32x2 vr, vi; vr.x = pk2(aR[mi][ni][0], aR[mi][ni][1]); vr.y = pk2(aR[mi][ni][2], aR[mi][ni][3]); vi.x = pk2(aI[mi][ni][0], aI[mi][ni][1]); vi.y = pk2(aI[mi][ni][2], aI[mi][ni][3]);
                *(u32x2*)(PT + o) = vr; *(u32x2*)(PT + (size_t)512 * T_ + o) = vi; }
    }
}

DEV void phase2(CParams& p, unsigned char* smem) {
    __syncthreads();
    for (int i = opq((int)threadIdx.x); i < 4096; i += NT) ((u32x4*)smem)[i] = ((const u32x4*)(PWS + OFF_TAB))[i];
    __syncthreads();
    { int tk = 0; for (int c = BID(); c < 512; c += NBLK(), ++tk) hyena_task(p, c, tk, smem); }
    for (int ch = BID(); ch < 512; ch += NBLK()) fnet_task(p, ch, smem);
}

DEV void tr16_wave(const bf16_t* __restrict__ src, int R, int C, int r0, int c0, bf16_t* __restrict__ dst, int lane) {
    const int rb = lane >> 3, cb = lane & 7;
    u32x4 in[8];
#pragma unroll
    for (int i = 0; i < 8; ++i) in[i] = *(const u32x4*)(src + (size_t)(r0 + 8 * rb + i) * C + c0 + 8 * cb);
#pragma unroll
    for (int j = 0; j < 8; ++j) { u32x4 o;
#pragma unroll
        for (int pp = 0; pp < 4; ++pp) { const unsigned a = in[2 * pp][j >> 1], b = in[2 * pp + 1][j >> 1];
            o[pp] = (j & 1) ? ((a >> 16) | (b & 0xffff0000u)) : ((a & 0xffffu) | (b << 16)); }
        *(u32x4*)(dst + (size_t)(c0 + 8 * cb + j) * R + r0 + 8 * rb) = o; }
}
DEV void phase3(CParams& p, unsigned char* smem) {
    const bool not256 = NBLK() != 256;
    const int tid = opq((int)threadIdx.x); const int lane = tid & 63, wave = tid >> 6;
    unsigned char* ws = opqp(PWS);
    const int bid = BID(), istep = NBLK() * 8;
    if (!not256) {
        const int g = bid & 7, wg = (bid >> 3) * 8 + wave;
        u32x4 in[3][8]; const int rb = lane >> 3, cbl = lane & 7;
#pragma unroll
        for (int k = 0; k < 3; ++k) { const int idx = wg + 256 * k, tb = 32 * g + (idx & 31), cb = idx >> 5;
            const bf16_t* s_ = k == 0 ? (const bf16_t*)(ws + OFF_ZHY) : (const bf16_t*)(ws + OFF_PRI); const int r0 = (k == 0 ? cb : cb - 8) * 64, c0 = tb * 64;
#pragma unroll
            for (int i = 0; i < 8; ++i) in[k][i] = *(const u32x4*)(s_ + (size_t)(r0 + 8 * rb + i) * T_ + c0 + 8 * cbl); }
#pragma unroll
        for (int k = 0; k < 3; ++k) { const int idx = wg + 256 * k, tb = 32 * g + (idx & 31), cb = idx >> 5;
            bf16_t* d_ = k == 0 ? (bf16_t*)(ws + OFF_ZR) : (bf16_t*)(ws + OFF_PR); const int R = k == 0 ? 512 : 1024, r0 = (k == 0 ? cb : cb - 8) * 64, c0 = tb * 64;
#pragma unroll
            for (int j = 0; j < 8; ++j) { u32x4 o;
#pragma unroll
                for (int pp = 0; pp < 4; ++pp) { const unsigned a = in[k][2 * pp][j >> 1], b = in[k][2 * pp + 1][j >> 1];
                    o[pp] = (j & 1) ? ((a >> 16) | (b & 0xffff0000u)) : ((a & 0xffffu) | (b << 16)); }
                *(u32x4*)(d_ + (size_t)(c0 + 8 * cbl + j) * R + r0 + 8 * rb) = o; } }
    } else
    for (int i = bid * 8 + wave; i < 6144; i += istep) {
        if (i < 2048) tr16_wave((const bf16_t*)(ws + OFF_ZHY), 512, T_, (i >> 8) * 64, (i & 255) * 64, (bf16_t*)(ws + OFF_ZR), lane);
        else { const int j = i - 2048; tr16_wave((const bf16_t*)(ws + OFF_PRI), 1024, T_, (j >> 8) * 64, (j & 255) * 64, (bf16_t*)(ws + OFF_PR), lane); }
    }
    if (not256) cvt8_rows(PIN(19), (unsigned*)(ws + OFF_V), (float*)(ws + OFF_VS), lane, wave, nullptr, true);
}

DEV void phase4(CParams& p, unsigned char* smem) {
    unsigned char* ws = opqp(PWS);
    const bf16_t* sg = (const bf16_t*)POUT;
    bf16_t* merged = (bf16_t*)(ws + OFF_MERGED);
    {
        auto f = [=](int row, int col0, f32x4 v0, f32x4 v1) { f32x4 g0, g1; unpack8v(*(const u32x4*)(sg + (size_t)row * 2048 + col0), g0, g1);
            *(u32x4*)(merged + (size_t)row * 1024 + col0) = pack8v(v0 * g0, v1 * g1); };
        run_gemm(smem, (const bf16_t*)(ws + OFF_ZR), (const bf16_t*)(ws + OFF_WHY), T_, 1024, 512, f);
    }
    {
        auto f = [=](int row, int col0, f32x4 v0, f32x4 v1) { f32x4 g0, g1, m0, m1; unpack8v(*(const u32x4*)(sg + (size_t)row * 2048 + 1024 + col0), g0, g1);
            unpack8v(*(const u32x4*)(merged + (size_t)row * 1024 + col0), m0, m1);
            *(u32x4*)(merged + (size_t)row * 1024 + col0) = pack8v(m0 + v0 * g0, m1 + v1 * g1); };
        run_gemm(smem, (const bf16_t*)(ws + OFF_PR), (const bf16_t*)(ws + OFF_W2), T_, 1024, 1024, f);
    }
}

DEV void phase5(CParams& p, unsigned char* smem) {
    unsigned char* ws = opqp(PWS);
    const float* x = PIN(0);
    bf16_t* x1b = (bf16_t*)(ws + OFF_HN); unsigned long long* ss1 = (unsigned long long*)(ws + OFF_SS1);
    const int lane_ = (int)threadIdx.x & 63;
    auto f = [=](int row, int col0, f32x4 v0, f32x4 v1) { const size_t o = (size_t)row * 1024 + col0;
        const f32x4 a = *(const f32x4*)(x + o) + v0, b = *(const f32x4*)(x + o + 4) + v1;
        *(u32x4*)(x1b + o) = pack8v(a, b);
        float q = a[0] * a[0] + a[1] * a[1] + a[2] * a[2] + a[3] * a[3] + b[0] * b[0] + b[1] * b[1] + b[2] * b[2] + b[3] * b[3];
        q += __shfl_xor(q, 16); q += __shfl_xor(q, 32);
        if (lane_ < 16) atomicAdd(ss1 + row, (unsigned long long)(q * 1048576.0f + 0.5f)); };
    run_gemm(smem, (const bf16_t*)(ws + OFF_MERGED), (const bf16_t*)(ws + OFF_WOUT), T_, 1024, 1024, f);
}

DEV void phase7(CParams& p, unsigned char* smem) {
    unsigned char* ws = opqp(PWS);
    bf16_t* qg = (bf16_t*)POUT;
    const unsigned long long* ss1 = (const unsigned long long*)(ws + OFF_SS1);
    auto f = [=](int row, int col0, f32x4 v0, f32x4 v1) { const float rs = rsqrtf((float)ss1[row] * (1.0f / (1024.0f * 1048576.0f)) + 1e-6f);
        *(u32x4*)(qg + (size_t)row * 2048 + col0) = pack8v(v0 * rs, v1 * rs); };
    run_gemm(smem, (const bf16_t*)(ws + OFF_HN), (const bf16_t*)(ws + OFF_WQ), T_, 2048, 1024, f);
}

DEV int mono(float x) { const int b = __float_as_int(x); return b ^ ((b >> 31) & 0x7fffffff); }
DEV float unmono(int k) { return __int_as_float(k ^ ((k >> 31) & 0x7fffffff)); }
#define INS16(Lk, v_) { int vv_ = (v_); _Pragma("unroll") for (int p_ = 0; p_ < 16; ++p_) { const int hi_ = max(Lk[p_], vv_); vv_ = min(Lk[p_], vv_); Lk[p_] = hi_; } }

#define CE_(a, b) { const int hi_ = max(a, b), lo_ = min(a, b); a = hi_; b = lo_; }
template <int N> DEV void bsort_desc(int (&v)[N]) {
#pragma unroll
    for (int k = 2; k <= N; k <<= 1)
#pragma unroll
        for (int j = k >> 1; j > 0; j >>= 1)
#pragma unroll
            for (int i = 0; i < N; ++i) { const int l = i ^ j; if (l > i) { if ((i & k) == 0) CE_(v[i], v[l]) else CE_(v[l], v[i]) } }
}
DEV void bmerge16(int (&v)[16]) {
#pragma unroll
    for (int j = 8; j > 0; j >>= 1)
#pragma unroll
        for (int i = 0; i < 16; ++i) { const int l = i ^ j; if (l > i) CE_(v[i], v[l]) }
}
template <int LO, int N, int R> DEV void oem_merge(int (&v)[32]) {
    if constexpr (2 * R < N) {
        oem_merge<LO, N, 2 * R>(v); oem_merge<LO + R, N, 2 * R>(v);
#pragma unroll
        for (int i = LO + R; i + R < LO + N; i += 2 * R) CE_(v[i], v[i + R])
    } else CE_(v[LO], v[LO + R])
}
template <int LO, int N> DEV void oem_sort(int (&v)[32]) {
    if constexpr (N > 1) { oem_sort<LO, N / 2>(v); oem_sort<LO + N / 2, N / 2>(v); oem_merge<LO, N, 1>(v); }
}
template <int CTRL> DEV void quad_merge16(int (&v)[16]) {
    int m[16];
#pragma unroll
    for (int i = 0; i < 16; ++i) m[i] = __builtin_amdgcn_update_dpp(0, v[15 - i], CTRL, 0xf, 0xf, false);
#pragma unroll
    for (int i = 0; i < 16; ++i) v[i] = max(v[i], m[i]);
    bmerge16(v);
}

DEV void phase8(CParams& p, unsigned char* smem) {
    const int tid = opq((int)threadIdx.x), lane = tid & 63, w = tid >> 6, r = lane & 15, q = lane >> 4;
    unsigned char* ws = opqp(PWS);
    float* sc = (float*)smem;
    int* tops = (int*)(smem + 67584);
    unsigned char* ctab = smem + 75776;
    const bf16_t* qg = (const bf16_t*)POUT;
    const bf16_t* keys = (const bf16_t*)(ws + OFF_KEYS);
    int* idxg = (int*)(ws + OFF_IDX); float* gg = (float*)(ws + OFF_G);
    __syncthreads();
    if (tid < 64) {
        const int L = tid >> 4, k = tid & 15; int v = 0xff;
        if (L == 0) v = k;
        else if (L == 1) v = k < 8 ? (1 << 4) | k : k < 12 ? (3 << 4) | (k - 8) : k < 15 ? (4 << 4) | (k - 12) : (8 << 4);
        else if (L == 2) v = k < 5 ? (2 << 4) | k : k < 11 ? ((5 + ((k - 5) >> 1)) << 4) | ((k - 5) & 1) : ((9 + (k - 11)) << 4);
        else v = k < 2 ? ((14 + k) << 4) : 0xff;
        ctab[tid] = (unsigned char)v;
    }
    unsigned char* qimg = smem + 75840;
    const int c = w >> 2, kb = 32 * (w & 3);
    pg8::StaticOrder SO; SO.init(T_, 2048, NBLK(), BID());
    auto item_of = [&](int j, int& tt, int& h) -> bool { pg8::Unit u; if (!SO.next(j >> 2, u)) return false; tt = u.pm * 4 + (j & 3); h = u.pn; return true; };
    bf16x8 bfr[4][2]; u32x4 qreg[4];
    const int qtok = tid >> 3, qch = tid & 7;
    int tt = 0, h = 0;
    bool have = item_of(0, tt, h);
    if (have) {
#pragma unroll
        for (int i = 0; i < 4; ++i) qreg[i] = *(const u32x4*)(qg + (size_t)(64 * tt + qtok) * 2048 + h * 256 + 8 * (qch + 8 * i));
    }
    for (int j = 0; have; ++j) {
        const int t0 = 64 * tt;
        if ((j & 3) == 0) {
#pragma unroll
            for (int s = 0; s < 4; ++s)
#pragma unroll
                for (int ni = 0; ni < 2; ++ni) bfr[s][ni] = *(const bf16x8*)(keys + (size_t)((h * 2 + c) * 128 + kb + 16 * ni + r) * 128 + 32 * s + 8 * q);
        }
        const int h_cur = h;
#pragma unroll
        for (int i = 0; i < 4; ++i) *(u32x4*)(qimg + img_off(qtok, qch + 8 * i, 64)) = qreg[i];
        __syncthreads();
        have = item_of(j + 1, tt, h);
        if (have) {
#pragma unroll
            for (int i = 0; i < 4; ++i) qreg[i] = *(const u32x4*)(qg + (size_t)(64 * tt + qtok) * 2048 + h * 256 + 8 * (qch + 8 * i));
        }
        f32x4 acc[4][2];
#pragma unroll
        for (int mi = 0; mi < 4; ++mi) { acc[mi][0] = (f32x4){0.f, 0.f, 0.f, 0.f}; acc[mi][1] = (f32x4){0.f, 0.f, 0.f, 0.f}; }
#pragma unroll
        for (int s = 0; s < 4; ++s)
#pragma unroll
            for (int mi = 0; mi < 4; ++mi) { const bf16x8 a = *(const bf16x8*)(qimg + img_off(16 * mi + r, 16 * c + 4 * s + q, 64));
                acc[mi][0] = mfma16(a, bfr[s][0], acc[mi][0]); acc[mi][1] = mfma16(a, bfr[s][1], acc[mi][1]); }
        __syncthreads();
#pragma unroll
        for (int mi = 0; mi < 4; ++mi)
#pragma unroll
            for (int ni = 0; ni < 2; ++ni)
#pragma unroll
                for (int i = 0; i < 4; ++i) sc[(c * 64 + 16 * mi + 4 * q + i) * 132 + kb + 16 * ni + r] = acc[mi][ni][i];
        __syncthreads();
        {
            const int row = tid >> 2, qd = tid & 3;
            const float* src = sc + row * 132 + 32 * qd;
            int v[32];
#pragma unroll
            for (int k4 = 0; k4 < 8; ++k4) { const f32x4 x = *(const f32x4*)(src + 4 * k4);
#pragma unroll
                for (int e = 0; e < 4; ++e) v[4 * k4 + e] = (mono(x[e]) & ~127) | (32 * qd + 4 * k4 + e); }
            oem_sort<0, 16>(v); oem_sort<16, 16>(v);
            int t16[16];
#pragma unroll
            for (int i = 0; i < 16; ++i) t16[i] = max(v[i], v[31 - i]);
            bmerge16(t16);
            quad_merge16<0xB1>(t16); quad_merge16<0x4E>(t16);
            if (qd == 0) {
#pragma unroll
                for (int k4 = 0; k4 < 4; ++k4) *(u32x4*)(tops + row * 16 + 4 * k4) = (u32x4){(unsigned)t16[4 * k4], (unsigned)t16[4 * k4 + 1], (unsigned)t16[4 * k4 + 2], (unsigned)t16[4 * k4 + 3]};
            }
        }
        __syncthreads();
        if (tid < 256) {
            const int tok = tid >> 2, L = tid & 3;
            const int* ta = tops + tok * 16; const int* tb = tops + (64 + tok) * 16;
            int m[16];
#pragma unroll
            for (int k = 0; k < 16; ++k) { const int cij = ctab[L * 16 + k];
                const float sa = unmono(ta[(cij >> 4) & 15] & ~127), sb = unmono(tb[cij & 15] & ~127);
                m[k] = cij == 0xff ? (int)0x80000000 : ((mono(sa + sb) & ~255) | cij); }
            bsort_desc<16>(m);
            quad_merge16<0xB1>(m); quad_merge16<0x4E>(m);
            if (L == 0) {
                float e[16]; float sum = 0.f; const float mx = unmono(m[0] & ~255);
#pragma unroll
                for (int k = 0; k < 16; ++k) { e[k] = __expf(unmono(m[k] & ~255) - mx); sum += e[k]; }
                const float inv = 1.0f / sum;
                int ex[16];
#pragma unroll
                for (int k = 0; k < 16; ++k) ex[k] = (ta[(m[k] >> 4) & 15] & 127) * 128 + (tb[m[k] & 15] & 127);
                const size_t ob = (size_t)(t0 + tok) * 128 + h_cur * 16;
#pragma unroll
                for (int k4 = 0; k4 < 4; ++k4) { *(u32x4*)(idxg + ob + 4 * k4) = (u32x4){(unsigned)ex[4 * k4], (unsigned)ex[4 * k4 + 1], (unsigned)ex[4 * k4 + 2], (unsigned)ex[4 * k4 + 3]};
                    *(f32x4*)(gg + ob + 4 * k4) = (f32x4){e[4 * k4] * inv, e[4 * k4 + 1] * inv, e[4 * k4 + 2] * inv, e[4 * k4 + 3] * inv}; }
            }
        }
    }
}

DEV void unpack8(u32x4 v, float* o) { o[0] = bf_lo(v.x); o[1] = bf_hi(v.x); o[2] = bf_lo(v.y); o[3] = bf_hi(v.y); o[4] = bf_lo(v.z); o[5] = bf_hi(v.z); o[6] = bf_lo(v.w); o[7] = bf_hi(v.w); }
DEV void unpack_fp8x16(u32x4 v, float* o) {
#pragma unroll
    for (int d = 0; d < 4; ++d) { const f32x2 lo = __builtin_amdgcn_cvt_pk_f32_fp8((int)v[d], false), hi = __builtin_amdgcn_cvt_pk_f32_fp8((int)v[d], true);
        o[4 * d] = lo.x; o[4 * d + 1] = lo.y; o[4 * d + 2] = hi.x; o[4 * d + 3] = hi.y; }
}
template <int CTRL> DEV float dpp_mov(float v) { return __int_as_float(__builtin_amdgcn_update_dpp(0, __float_as_int(v), CTRL, 0xf, 0xf, false)); }
DEV float row_allreduce16(float v) {
    v += dpp_mov<0x128>(v); v += dpp_mov<0x124>(v); v += dpp_mov<0x122>(v); v += dpp_mov<0x121>(v); return v;
}
struct Place { int nx, vx, nloc, rank; };
template <int CTRL> DEV float dppf(float v) { return __int_as_float(__builtin_amdgcn_update_dpp(0, __float_as_int(v), CTRL, 0xf, 0xf, false)); }

DEV float wave_sum_dpp(float v) {
    v += dppf<0x128>(v); v += dppf<0x124>(v); v += dppf<0x122>(v); v += dppf<0x121>(v);
    const int b = __float_as_int(v);
    return __int_as_float(__builtin_amdgcn_readlane(b, 0)) + __int_as_float(__builtin_amdgcn_readlane(b, 16)) + __int_as_float(__builtin_amdgcn_readlane(b, 32)) + __int_as_float(__builtin_amdgcn_readlane(b, 48));
}
template <int CTRL> DEV int dppi(int v) { return __builtin_amdgcn_update_dpp(0, v, CTRL, 0xf, 0xf, false); }
typedef __attribute__((address_space(1))) unsigned char* gbptr;
DEV gbptr uni_base(const unsigned char* q) { const unsigned long long v = (unsigned long long)q; const unsigned lo = __builtin_amdgcn_readfirstlane((unsigned)v), hi = __builtin_amdgcn_readfirstlane((unsigned)(v >> 32));
    return (gbptr)(((unsigned long long)hi << 32) | lo); }
#define GLD(TYPE, BASE, OFF) (*(const __attribute__((address_space(1))) TYPE*)((BASE) + (unsigned)(OFF)))
#define GST(TYPE, BASE, OFF) (*(__attribute__((address_space(1))) TYPE*)((BASE) + (unsigned)(OFF)))
DEV void quant_x1(CParams& p) {
    const int tid = opq((int)threadIdx.x); const int lane = tid & 63, wave = tid >> 6;
    unsigned char* ws = opqp(PWS);
    const bf16_t* x1b = (const bf16_t*)(ws + OFF_HN); unsigned char* xq = ws + OFF_XQ; float* hsg = (float*)(ws + OFF_HS);
    const int nb_ = NBLK(), bid_ = BID();
    const bool grp_ = nb_ == 256;
    const int rstep = grp_ ? 4 : nb_ * 32, rfirst = grp_ ? 2048 * (bid_ & 7) + 64 * (bid_ >> 3) + 8 * wave : (bid_ * 8 + wave) * 4, rend = grp_ ? rfirst + 8 : T_;
    for (int row0 = rfirst; row0 < rend; row0 += rstep) {
        u32x4 h0[4], h1[4];
#pragma unroll
        for (int k = 0; k < 4; ++k) { h0[k] = *(const u32x4*)(x1b + (size_t)(row0 + k) * 1024 + 16 * lane); h1[k] = *(const u32x4*)(x1b + (size_t)(row0 + k) * 1024 + 16 * lane + 8); }
#pragma unroll
        for (int k = 0; k < 4; ++k) { float hf[16];
            hf[0] = bf_lo(h0[k].x); hf[1] = bf_hi(h0[k].x); hf[2] = bf_lo(h0[k].y); hf[3] = bf_hi(h0[k].y); hf[4] = bf_lo(h0[k].z); hf[5] = bf_hi(h0[k].z); hf[6] = bf_lo(h0[k].w); hf[7] = bf_hi(h0[k].w);
            hf[8] = bf_lo(h1[k].x); hf[9] = bf_hi(h1[k].x); hf[10] = bf_lo(h1[k].y); hf[11] = bf_hi(h1[k].y); hf[12] = bf_lo(h1[k].z); hf[13] = bf_hi(h1[k].z); hf[14] = bf_lo(h1[k].w); hf[15] = bf_hi(h1[k].w);
            float m_ = 0.f;
#pragma unroll
            for (int i = 0; i < 16; ++i) m_ = fmaxf(m_, fabsf(hf[i]));
            int mi = __float_as_int(m_);
            mi = max(mi, dppi<0xB1>(mi)); mi = max(mi, dppi<0x4E>(mi)); mi = max(mi, dppi<0x141>(mi));
            m_ = __int_as_float(mi);
            const float inv_ = m_ > 0.f ? 127.0f / m_ : 0.f;
            u32x4 qv;
#pragma unroll
            for (int j = 0; j < 4; ++j) qv[j] = pack_i8x4(hf[4 * j], hf[4 * j + 1], hf[4 * j + 2], hf[4 * j + 3], inv_);
            *(u32x4*)(xq + (size_t)(row0 + k) * 1024 + 16 * lane) = qv;
            if ((lane & 7) == 0) hsg[(row0 + k) * 8 + (lane >> 3)] = m_ * (1.0f / 127.0f); }
    }
}
#define P9_HTAKE() { hq[0] = (int)hn_.x; hq[1] = (int)hn_.y; hq[2] = (int)hn_.z; hq[3] = (int)hn_.w; hs = hsn_; }
#define P9_COMP(D, OUT) { int tt[8]; _Pragma("unroll") for (int k = 0; k < 8; ++k) { int a_ = __builtin_amdgcn_sdot4((int)D[k][0], hq[0], 0, false); a_ = __builtin_amdgcn_sdot4((int)D[k][1], hq[1], a_, false); \
        a_ = __builtin_amdgcn_sdot4((int)D[k][2], hq[2], a_, false); tt[k] = __builtin_amdgcn_sdot4((int)D[k][3], hq[3], a_, false); } \
    const int v0_ = tt[0] + dppi<0x141>(tt[4]), v1_ = tt[1] + dppi<0x141>(tt[5]), v2_ = tt[2] + dppi<0x141>(tt[6]), v3_ = tt[3] + dppi<0x141>(tt[7]); \
    const int w0_ = (b1 ? v2_ : v0_) + dppi<0x4E>(b1 ? v0_ : v2_), w1_ = (b1 ? v3_ : v1_) + dppi<0x4E>(b1 ? v1_ : v3_); \
    OUT = (b0 ? w1_ : w0_) + dppi<0xB1>(b0 ? w0_ : w1_); }
#define P11_COMP(D, W) { _Pragma("unroll") for (int st = 0; st < 2; ++st) { _Pragma("unroll") for (int j = 0; j < 4; ++j) { \
        const unsigned a_ = D[4 * st][j], b_ = D[4 * st + 1][j], c_ = D[4 * st + 2][j], d_ = D[4 * st + 3][j]; \
        const unsigned p_ = __builtin_amdgcn_perm(b_, a_, 0x05010400u), pp_ = __builtin_amdgcn_perm(b_, a_, 0x07030602u), r_ = __builtin_amdgcn_perm(d_, c_, 0x05010400u), rr_ = __builtin_amdgcn_perm(d_, c_, 0x07030602u); \
        acc[4 * j]     = __builtin_amdgcn_sdot4((int)__builtin_amdgcn_perm(r_, p_, 0x05040100u), W[st], acc[4 * j], false); \
        acc[4 * j + 1] = __builtin_amdgcn_sdot4((int)__builtin_amdgcn_perm(r_, p_, 0x07060302u), W[st], acc[4 * j + 1], false); \
        acc[4 * j + 2] = __builtin_amdgcn_sdot4((int)__builtin_amdgcn_perm(rr_, pp_, 0x05040100u), W[st], acc[4 * j + 2], false); \
        acc[4 * j + 3] = __builtin_amdgcn_sdot4((int)__builtin_amdgcn_perm(rr_, pp_, 0x07060302u), W[st], acc[4 * j + 3], false); } } }
DEV int swap_add32(int a, int b) { const auto r = __builtin_amdgcn_permlane32_swap((unsigned)a, (unsigned)b, false, false); return (int)(r[0] + r[1]); }
DEV int swap_add16(int a, int b) { const auto r = __builtin_amdgcn_permlane16_swap((unsigned)a, (unsigned)b, false, false); return (int)(r[0] + r[1]); }
#define TL_REQ_U(K) { const unsigned tb_ = ((unsigned)(((K) >> 1) & 7) << 9) + 256 * ((K) & 1); const u32x4 i0_ = *(const u32x4*)(idxl + tb_ + ioA), i1_ = *(const u32x4*)(idxl + tb_ + ioB); \
    r_ie[0] = (int)i0_.x; r_ie[1] = (int)i0_.y; r_ie[2] = (int)i0_.z; r_ie[3] = (int)i0_.w; r_ie[4] = (int)i1_.x; r_ie[5] = (int)i1_.y; r_ie[6] = (int)i1_.z; r_ie[7] = (int)i1_.w; }
#define TL_HLOAD(N) { const unsigned t_ = (unsigned)(t0 + ((N) & 7)), s_ = (unsigned)(N) >> 3; hn_ = GLD(u32x4, xqb, (t_ << 10) + (s_ << 7) + l16); hsn_ = GLD(float, hsb, (t_ << 5) + (s_ << 2)); }
#define TL_ISSUE_U(D, K) { const gbptr ub_ = ub + ((size_t)((K) >> 4) << 21); _Pragma("unroll") for (int k = 0; k < 8; ++k) D[k] = GLD(u32x4, ub_, ((unsigned)r_ie[k] << 7) + l16); }
#define TL_REQ_V(K) { const unsigned tb_ = ((unsigned)(((K) >> 1) & 7) << 9) + 256 * ((K) & 1); const u32x4 i0_ = *(const u32x4*)(idxl + tb_ + g32), i1_ = *(const u32x4*)(idxl + tb_ + g32 + 16); \
    r_ie[0] = (int)i0_.x; r_ie[1] = (int)i0_.y; r_ie[2] = (int)i0_.z; r_ie[3] = (int)i0_.w; r_ie[4] = (int)i1_.x; r_ie[5] = (int)i1_.y; r_ie[6] = (int)i1_.z; r_ie[7] = (int)i1_.w; }
#define TL_ISSUE_V(D, K) { const gbptr vb_ = vb + ((size_t)((K) >> 4) << 21); _Pragma("unroll") for (int k = 0; k < 8; ++k) D[k] = GLD(u32x4, vb_, ((unsigned)r_ie[k] << 7) + l16); }
#define TL_STEP_U(DCUR, DNEXT, K, OUT) { if ((K) + 2 < 128) TL_ISSUE_U(DNEXT, (K) + 2); if ((K) + 3 < 128) TL_REQ_U((K) + 3); P9_COMP(DCUR, OUT); }
#define TL_STEP_V(DCUR, DNEXT, K) { const u32x2 w_ = *(const u32x2*)(wq + (((K) >> 1) & 7) * 128 + 64 * ((K) & 1) + g8);        \
    if ((K) + 2 < 128) TL_ISSUE_V(DNEXT, (K) + 2); if ((K) + 3 < 128) TL_REQ_V((K) + 3); int W_[2]; W_[0] = (int)w_.x; W_[1] = (int)w_.y; P11_COMP(DCUR, W_); }
#define TL_VOUT(N) { int n8[8], n4[4]; \
    _Pragma("unroll") for (int i = 0; i < 8; ++i) n8[i] = swap_add32(acc[i], acc[i + 8]); \
    _Pragma("unroll") for (int i = 0; i < 4; ++i) n4[i] = swap_add16(n8[i], n8[i + 4]); \
    const int f0 = (b3 ? n4[2] : n4[0]) + dppi<0x128>(b3 ? n4[0] : n4[2]), f1 = (b3 ? n4[3] : n4[1]) + dppi<0x128>(b3 ? n4[1] : n4[3]); \
    const float wscale = wscl[(N) & 7]; \
    GST(unsigned, pob, ((unsigned)(t0 + ((N) & 7)) << 11) + ((unsigned)((N) >> 3) << 8) + 2 * eoff) = pk2((float)f0 * wscale, (float)f1 * wscale); \
    _Pragma("unroll") for (int j = 0; j < 16; ++j) acc[j] = 0; }
DEV void phase_tail(CParams& p, unsigned char* smem) {
    const int tid = opq((int)threadIdx.x); const int lane = tid & 63, wave = __builtin_amdgcn_readfirstlane(tid >> 6), gi = lane >> 3, li = lane & 7;
    unsigned char* ws = opqp(PWS);
    const gbptr idxb = uni_base(ws + OFF_IDX), ub = uni_base(ws + OFF_U), vb = uni_base(ws + OFF_V), xqb = uni_base(ws + OFF_XQ), hsb = uni_base(ws + OFF_HS),
                ggb = uni_base(ws + OFF_G), pob = uni_base(ws + OFF_PO);
    const float* us = (const float*)(ws + OFF_US); const float* vs = (const float*)(ws + OFF_VS); const unsigned long long* ss1 = (const unsigned long long*)(ws + OFF_SS1);
    const bf16_t* x1b = (const bf16_t*)(ws + OFF_HN); const float* gfin = PIN(20);
    float* dots = (float*)(smem + wave * 10240); unsigned char* wq = smem + wave * 10240 + 4096; float* wscl = (float*)(smem + wave * 10240 + 5120); const unsigned char* idxl = smem + wave * 10240 + 6144;
    const int q4 = (li >> 2) & 1; const bool b1 = (li & 2) != 0, b0 = (li & 1) != 0;
    const unsigned ioA = 4 * (8 * gi + 4 * q4), ioB = 4 * (8 * gi + 4 * (1 - q4));
    const unsigned l16 = 16 * li, g32 = 32 * gi, g8 = 8 * gi;
    const bool b3 = (lane & 8) != 0, b4 = (lane & 16) != 0, b5 = (lane & 32) != 0;
    const int eoff = 16 * li + (b5 ? 8 : 0) + (b4 ? 4 : 0) + (b3 ? 2 : 0);
    const float eps_ = __int_as_float(opq(__float_as_int(1e-6f)));
    const int nb_ = NBLK(), ostep = nb_ * 8; const bool grp_ = nb_ == 256;
    for (int oct = BID() * 8 + wave; oct < T_ / 8; oct += ostep) {
        const int t0 = grp_ ? 2048 * ((oct >> 3) & 7) + 64 * (oct >> 6) + 8 * (oct & 7) : oct * 8;
#pragma unroll
        for (int i = 0; i < 16; ++i) dots[i * 64 + lane] = 0.f;
#pragma unroll
        for (int i = 0; i < 4; ++i) *(u32x4*)(smem + wave * 10240 + 6144 + 1024 * i + 16 * lane) = GLD(u32x4, idxb, ((unsigned)t0 << 9) + 1024 * i + 16 * lane);
        int r_ie[8]; u32x4 D0[8], D1[8], D2[8], D3[8];
        {
            u32x4 hn_; float hsn_; int hq[4]; float hs;
            TL_REQ_U(0); TL_HLOAD(0); TL_ISSUE_U(D0, 0); TL_REQ_U(1); TL_ISSUE_U(D1, 1); TL_REQ_U(2);
            P9_HTAKE();
#pragma unroll 1
            for (int k0 = 0; k0 < 128; k0 += 4) {
                const int n = k0 >> 1;
                int o0, o1;
                TL_STEP_U(D0, D2, k0, o0);
                TL_HLOAD(n + 1);
                TL_STEP_U(D1, D3, k0 + 1, o1);
                { float* dp = dots + (n & 7) * 128 + lane; dp[0] += (float)o0 * hs; dp[64] += (float)o1 * hs; }
                P9_HTAKE();
                TL_STEP_U(D2, D0, k0 + 2, o0);
                if (n + 2 < 64) TL_HLOAD(n + 2);
                TL_STEP_U(D3, D1, k0 + 3, o1);
                { float* dp = dots + ((n + 1) & 7) * 128 + lane; dp[0] += (float)o0 * hs; dp[64] += (float)o1 * hs; }
                if (n + 2 < 64) P9_HTAKE();
            }
        }
        TL_REQ_V(0); TL_ISSUE_V(D0, 0); TL_REQ_V(1); TL_ISSUE_V(D1, 1); TL_REQ_V(2);
#pragma unroll
        for (int tk = 0; tk < 8; ++tk) {
            const unsigned t = (unsigned)(t0 + tk);
            const int e0 = GLD(int, idxb, (t << 9) + 4 * lane), e1 = GLD(int, idxb, (t << 9) + 256 + 4 * lane);
            const float g0 = GLD(float, ggb, (t << 9) + 4 * lane), g1 = GLD(float, ggb, (t << 9) + 256 + 4 * lane);
            const float rs = rsqrtf((float)ss1[t] * (1.0f / (1024.0f * 1048576.0f)) + 1e-6f);
            const float x0 = dots[tk * 128 + lane] * us[e0] * rs, x1 = dots[tk * 128 + 64 + lane] * us[e1] * rs;
            const float w0 = g0 * 0.5f * x0 * (1.0f + erff(x0 * 0.70710678118654752f)) * vs[e0], w1 = g1 * 0.5f * x1 * (1.0f + erff(x1 * 0.70710678118654752f)) * vs[e1];
            int mi = __float_as_int(fmaxf(fabsf(w0), fabsf(w1)));
            mi = max(mi, dppi<0x128>(mi)); mi = max(mi, dppi<0x124>(mi)); mi = max(mi, dppi<0x122>(mi)); mi = max(mi, dppi<0x121>(mi));
            mi = max(max(__builtin_amdgcn_readlane(mi, 0), __builtin_amdgcn_readlane(mi, 16)), max(__builtin_amdgcn_readlane(mi, 32), __builtin_amdgcn_readlane(mi, 48)));
            const float m = __int_as_float(mi);
            const float inv = m > 0.f ? 127.0f / m : 0.f;
            wq[tk * 128 + lane] = (unsigned char)__float_as_uint(fmaf(w0, inv, 12582912.0f)); wq[tk * 128 + 64 + lane] = (unsigned char)__float_as_uint(fmaf(w1, inv, 12582912.0f));
            if (lane == 0) wscl[tk] = m * (1.0f / 127.0f);
        }
        {
            int acc[16];
#pragma unroll
            for (int j = 0; j < 16; ++j) acc[j] = 0;
#pragma unroll 1
            for (int k0 = 0; k0 < 128; k0 += 4) {
                const int n = k0 >> 1;
                TL_STEP_V(D0, D2, k0);
                TL_STEP_V(D1, D3, k0 + 1);
                TL_VOUT(n);
                TL_STEP_V(D2, D0, k0 + 2);
                TL_STEP_V(D3, D1, k0 + 3);
                TL_VOUT(n + 1);
            }
        }
        asm volatile("s_waitcnt vmcnt(0)" ::: "memory");
        __builtin_amdgcn_fence(__ATOMIC_SEQ_CST, "workgroup");
#pragma unroll 1
        for (int r4 = 0; r4 < 2; ++r4) {
            const int row0 = t0 + 4 * r4;
            f32x4 v[4][4]; float ss[4];
#pragma unroll
            for (int k = 0; k < 4; ++k)
#pragma unroll
                for (int i = 0; i < 4; ++i) { const u32x2 xv = *(const u32x2*)(x1b + (size_t)(row0 + k) * 1024 + 4 * lane + 256 * i);
                    const u32x2 pv = GLD(u32x2, pob, ((unsigned)(row0 + k) << 11) + 8 * lane + 512 * i);
                    v[k][i] = (f32x4){bf_lo(xv.x), bf_hi(xv.x), bf_lo(xv.y), bf_hi(xv.y)} + (f32x4){bf_lo(pv.x), bf_hi(pv.x), bf_lo(pv.y), bf_hi(pv.y)}; }
#pragma unroll
            for (int k = 0; k < 4; ++k) { ss[k] = 0.f;
#pragma unroll
                for (int i = 0; i < 4; ++i) ss[k] += v[k][i][0] * v[k][i][0] + v[k][i][1] * v[k][i][1] + v[k][i][2] * v[k][i][2] + v[k][i][3] * v[k][i][3]; }
#pragma unroll
            for (int o = 32; o; o >>= 1) {
#pragma unroll
                for (int k = 0; k < 4; ++k) ss[k] += __shfl_xor(ss[k], o); }
#pragma unroll
            for (int i = 0; i < 4; ++i) { const f32x4 gv = *(const f32x4*)(gfin + 4 * lane + 256 * i);
#pragma unroll
                for (int k = 0; k < 4; ++k) { const float sc = rsqrtf(ss[k] * (1.0f / 1024.0f) + eps_);
                    *(f32x4*)(POUT + (size_t)(row0 + k) * 1024 + 4 * lane + 256 * i) = v[k][i] * sc * gv; } }
        }
    }
}

#define LAS __attribute__((address_space(3)))
#define XB_TMO      128
#define XB_XCNT(j)  (256  + 64 * (j))
#define XB_XSUB(j)  (1280 + 64 * (j))
#define XB_XGEN(j)  (2304 + 64 * (j))
#define XB_TOP      3328
#define XB_TOPGEN   3392
#define XCD_BAR_WORDS 3456
#define XB_SPIN_CAP (1u << 18)

__device__ __forceinline__ unsigned xb_ld(unsigned* p)              { return __hip_atomic_load(p, __ATOMIC_RELAXED, __HIP_MEMORY_SCOPE_AGENT); }
__device__ __forceinline__ unsigned xb_add(unsigned* p, unsigned v) { return __hip_atomic_fetch_add(p, v, __ATOMIC_RELAXED, __HIP_MEMORY_SCOPE_AGENT); }
__device__ __forceinline__ unsigned xb_xcc_id() { return (unsigned)__builtin_amdgcn_s_getreg((3 << 11) | 20) & 0xFu; }
#define XB_SPIN(cond, bar) do { unsigned _sp = 0; while (cond) { __builtin_amdgcn_s_sleep(1); \
    if ((++_sp & 255u) == 0u) { if (xb_ld(&(bar)[XB_TMO])) break; if (_sp > XB_SPIN_CAP) { atomicAdd(&(bar)[XB_TMO], 1u); break; } } } } while (0)

struct XcdBarrier {
    unsigned* bar; unsigned x;
    volatile LAS unsigned* st;
};

__device__ __forceinline__ XcdBarrier xcd_barrier_post(unsigned* bar, volatile LAS unsigned* st) {
    XcdBarrier b; b.bar = bar; b.x = xb_xcc_id(); b.st = st;
    if (threadIdx.x == 0) (void)xb_add(&bar[XB_XCNT(b.x)], 1u);
    return b;
}
__device__ __forceinline__ void xcd_barrier_complete(unsigned* bar, unsigned x, unsigned& nloc, unsigned& nx) {
    const unsigned G = NBLK() * gridDim.y * gridDim.z;
    unsigned sum, cnt, mine, sp = 0u;
    for (;;) {
        sum = 0u; cnt = 0u; mine = 0u;
#pragma unroll 1
        for (unsigned j = 0; j < 16; ++j) { const unsigned c = xb_ld(&bar[XB_XCNT(j)]); sum += c; cnt += (c > 0u) ? 1u : 0u; mine = (j == x) ? c : mine; }
        if (sum == G) break;
        __builtin_amdgcn_s_sleep(1);
        if ((++sp & 255u) == 0u) { if (xb_ld(&bar[XB_TMO])) break; if (sp > XB_SPIN_CAP) { atomicAdd(&bar[XB_TMO], 1u); break; } }
    }
    nloc = mine > 0u ? mine : 1u; nx = cnt > 0u ? cnt : 1u;
}

__device__ __forceinline__ void xcd_barrier(const XcdBarrier& b) {
    asm volatile("s_waitcnt vmcnt(0)" ::: "memory");
    __syncthreads();
    if (threadIdx.x == 0) {
        unsigned* bar = b.bar;
        __builtin_amdgcn_s_waitcnt(0);
        unsigned nloc = b.st[0], nx = b.st[1];
        if (nloc == 0u) { xcd_barrier_complete(bar, (unsigned)opqs((int)b.x), nloc, nx); b.st[0] = nloc; b.st[1] = nx; }
        const unsigned old = xb_add(&bar[XB_XSUB(b.x)], 1u);
        const unsigned gen = old / nloc;
        if (old + 1u == (gen + 1u) * nloc) {
            __builtin_amdgcn_fence(__ATOMIC_RELEASE, "agent");
            asm volatile("s_waitcnt vmcnt(0)" ::: "memory");
            const unsigned og = xb_add(&bar[XB_TOP], 1u);
            const unsigned tg = og / nx;
            if (og + 1u == (tg + 1u) * nx) xb_add(&bar[XB_TOPGEN], 1u);
            else XB_SPIN(xb_ld(&bar[XB_TOPGEN]) == tg, bar);
            __builtin_amdgcn_fence(__ATOMIC_ACQUIRE, "agent");
            xb_add(&bar[XB_XGEN(b.x)], 1u);
            asm volatile("s_waitcnt vmcnt(0)" ::: "memory");
        } else {
            XB_SPIN(xb_ld(&bar[XB_XGEN(b.x)]) == gen, bar);
            __builtin_amdgcn_fence(__ATOMIC_ACQUIRE, "agent");
            asm volatile("s_waitcnt vmcnt(0)" ::: "memory");
        }
    }
    __syncthreads();
}


#define XB_RANK(j)  (3520 + 64 * (j))
#define GRP_SUB(g)  (5120 + 64 * (g))
#define GRP_GEN(g)  (5632 + 64 * (g))
#define GRP_XM(g)   (6144 + 64 * (g))
__device__ __forceinline__ void grp_barrier(unsigned* bar, unsigned g, unsigned n) {
    asm volatile("s_waitcnt vmcnt(0)" ::: "memory");
    __syncthreads();
    if (threadIdx.x == 0) {
        __builtin_amdgcn_s_waitcnt(0);
        const unsigned old = xb_add(&bar[GRP_SUB(g)], 1u);
        const unsigned gen = old / n;
        if (old + 1u == (gen + 1u) * n) xb_add(&bar[GRP_GEN(g)], 1u);
        else XB_SPIN(xb_ld(&bar[GRP_GEN(g)]) == gen, bar);
        __builtin_amdgcn_fence(__ATOMIC_ACQUIRE, "agent");
        asm volatile("s_waitcnt vmcnt(0)" ::: "memory");
    }
    __syncthreads();
}
DEV Place get_place(const XcdBarrier& b, volatile LAS unsigned* bst, unsigned char* ws, bool multi) {
    Place pl;
    if (!multi) { pl.nx = 1; pl.vx = 0; pl.nloc = (int)NBLK(); pl.rank = (int)BID(); return pl; }
    __syncthreads();
    if (threadIdx.x == 0) {
        unsigned* bar = (unsigned*)(ws + OFF_BAR); unsigned nx = 0, vx = 0, mine = 1; const unsigned myx = (unsigned)opqs((int)b.x);
#pragma unroll 1
        for (unsigned j = 0; j < 16; ++j) { const unsigned c = xb_ld(&bar[XB_XCNT(j)]); nx += c > 0u ? 1u : 0u; vx += (c > 0u && j < myx) ? 1u : 0u; mine = (j == myx && c > 0u) ? c : mine; }
        if (nx == 0u) nx = 1u;
        if (nx > 8u) { vx = vx % 8u; nx = 8u; }
        bst[3] = nx; bst[4] = vx; bst[5] = mine;
    }
    __syncthreads();
    pl.nx = (int)bst[3]; pl.vx = (int)bst[4]; pl.nloc = (int)bst[5]; pl.rank = (int)bst[2];
    if (pl.rank >= pl.nloc) pl.rank = pl.rank % pl.nloc;
    return pl;
}

__global__ void __launch_bounds__(NT) fwd_kernel(Params p_arg) {
    __shared__ __attribute__((aligned(16))) unsigned char smem[SMEM_BYTES];
    CParams* kp = (CParams*)__builtin_amdgcn_kernarg_segment_ptr();
    const int ph_lo = kp->ph_lo, ph_hi = kp->ph_hi;
    volatile LAS unsigned* bst = (volatile LAS unsigned*)((LAS unsigned char*)smem + 131072 + 256);
    if (threadIdx.x == 0) { bst[0] = 0u; bst[1] = 0u; bst[6] = 0u; }
    __syncthreads();
    XcdBarrier xbar{};
    const bool multi = ph_hi - ph_lo > 1;
    if (multi) {
        xbar = xcd_barrier_post((unsigned*)(((unsigned char*)kp->ws) + OFF_BAR), bst);
        if (threadIdx.x == 0) bst[2] = xb_add((unsigned*)(((unsigned char*)kp->ws) + OFF_BAR) + XB_RANK(xbar.x), 1u);
        if (threadIdx.x == 0) __hip_atomic_fetch_or((unsigned*)(((unsigned char*)kp->ws) + OFF_BAR) + GRP_XM(blockIdx.x & 7u), 1u << xbar.x, __ATOMIC_RELAXED, __HIP_MEMORY_SCOPE_AGENT);
    }
#define RUN_PHASE(K, CALL) if (ph_lo <= (K) && (K) < ph_hi) { asm volatile("" : "+s"(kp)); CParams& p = *kp; CALL; if ((K) + 1 < ph_hi) xcd_barrier(xbar); }
    RUN_PHASE(0, phase0(p, smem))
    RUN_PHASE(1, phase1(p, smem))
    RUN_PHASE(2, phase2(p, smem))
    if (multi && ph_lo <= 2 && 3 < ph_hi) {
        if (threadIdx.x == 0) { unsigned* bar = (unsigned*)(((unsigned char*)kp->ws) + OFF_BAR); unsigned ok = (NBLK() == 256) ? 1u : 0u;
#pragma unroll 1
            for (unsigned g = 0; g < 8; ++g) { const unsigned m = xb_ld(&bar[GRP_XM(g)]); ok &= (m != 0u && (m & (m - 1u)) == 0u) ? 1u : 0u; }
            bst[6] = ok; }
        __syncthreads();
    }
#define RUN_PHASE_G(K, CALL) if (ph_lo <= (K) && (K) < ph_hi) { asm volatile("" : "+s"(kp)); CParams& p = *kp; CALL; if ((K) + 1 < ph_hi) { \
        if (ph_lo <= 2 && bst[6] != 0u) grp_barrier((unsigned*)(((unsigned char*)kp->ws) + OFF_BAR), blockIdx.x & 7u, 32u); else xcd_barrier(xbar); } }
    RUN_PHASE_G(3, phase3(p, smem))
    RUN_PHASE_G(4, phase4(p, smem))
    RUN_PHASE_G(5, phase5(p, smem))
    RUN_PHASE_G(6, { quant_x1(p); phase7(p, smem); asm volatile("s_waitcnt vmcnt(0)" ::: "memory"); __syncthreads(); phase8(p, smem); })
    RUN_PHASE(7, phase_tail(p, smem))
#undef RUN_PHASE_G
#undef RUN_PHASE
}

extern "C" void kernel_launch(void* const* d_in, const int* in_sizes, int n_in, void* d_out, int out_size, void* d_ws, size_t ws_size, hipStream_t stream) {
    static int grid = 0;
    if (grid == 0) {
        if (n_in != 21 || out_size != T_ * 1024 || ws_size < WS_NEED) { fprintf(stderr, "kernel_launch: unexpected problem (n_in %d, out %d, ws %zu)\n", n_in, out_size, ws_size); grid = -1; return; }
        int dev = 0, cus = 0, per_cu = 0;
        (void)hipGetDevice(&dev);
        (void)hipDeviceGetAttribute(&cus, hipDeviceAttributeMultiprocessorCount, dev);
        (void)hipOccupancyMaxActiveBlocksPerMultiprocessor(&per_cu, (const void*)fwd_kernel, NT, 0);
        if (per_cu < 1 || cus < 1) { fprintf(stderr, "kernel_launch: occupancy query says %d blocks/CU on %d CUs\n", per_cu, cus); grid = -1; return; }
        grid = cus > 256 ? 256 : cus;
    }
    if (grid < 0) return;
    Params p{};
    for (int i = 0; i < 21; ++i) p.in[i] = (const float*)d_in[i];
    p.out = (float*)d_out; p.ws = (unsigned char*)d_ws;
#if N_LAUNCHES == 1
    p.ph_lo = 0; p.ph_hi = NPHASE;
    (void)hipMemsetAsync((unsigned char*)d_ws + OFF_BAR, 0, 32768, stream);
    void* args[] = {&p};
    hipError_t e = hipLaunchCooperativeKernel((const void*)fwd_kernel, dim3(grid), dim3(NT), args, 0, stream);
    if (e != hipSuccess) fprintf(stderr, "cooperative launch failed: %s (grid %d)\n", hipGetErrorString(e), grid);
#else
    for (int ph = 0; ph < NPHASE; ++ph) { p.ph_lo = ph; p.ph_hi = ph + 1;
        hipLaunchKernelGGL(fwd_kernel, dim3(grid), dim3(NT), 0, stream, p); }
#endif
}
```

```cpp
#include <hip/hip_runtime.h>
#include <cstdio>
#include <cstdint>

#ifndef N_LAUNCHES
#define N_LAUNCHES 1
#endif

typedef unsigned short bf16_t;
typedef short bf16x8 __attribute__((ext_vector_type(8)));
typedef float f32x4 __attribute__((ext_vector_type(4)));
typedef float f32x2 __attribute__((ext_vector_type(2)));
typedef unsigned u32x4 __attribute__((ext_vector_type(4)));
typedef unsigned u32x2 __attribute__((ext_vector_type(2)));

#define DEV __device__ __forceinline__
#define RQ { const int lq_ = opq(lane); r = lq_ & 15; q = lq_ >> 4; }

constexpr int T_ = 16384, L_ = 8192, NT = 512, NPHASE = 9;
constexpr size_t MiB = (size_t)1 << 20;
constexpr size_t OFF_HN = 0;
constexpr size_t OFF_WIN = 32 * MiB;
constexpr size_t OFF_WQ = 40 * MiB;
constexpr size_t OFF_WOUT = 44 * MiB;
constexpr size_t OFF_WHY = 46 * MiB;
constexpr size_t OFF_WFN = 47 * MiB;
constexpr size_t OFF_W2 = 48 * MiB;
constexpr size_t OFF_W3 = 50 * MiB;
constexpr size_t OFF_KEYS = 50 * MiB + 256 * 1024;
constexpr size_t OFF_HDN2 = 50 * MiB + 768 * 1024;
constexpr size_t OFF_DT = 51 * MiB + 768 * 1024;
constexpr size_t OFF_TAB = OFF_DT + 64 * 1024;
constexpr size_t OFF_PT = 52 * MiB;
constexpr size_t OFF_HF = 116 * MiB;
constexpr size_t OFF_ZHY = 148 * MiB;
constexpr size_t OFF_PRI = 164 * MiB;
constexpr size_t OFF_U = 196 * MiB;
constexpr size_t OFF_US = 212 * MiB;
constexpr size_t OFF_SS1 = 212 * MiB + 64 * 1024;
constexpr size_t OFF_BAR = 51 * MiB + 896 * 1024;
constexpr size_t OFF_ZR = 84 * MiB;
constexpr size_t OFF_PR = 116 * MiB;
constexpr size_t OFF_MERGED = 52 * MiB;
constexpr size_t OFF_V = 240 * MiB;
constexpr size_t OFF_VS = 212 * MiB + 256 * 1024;
constexpr size_t OFF_IDX = 216 * MiB;
constexpr size_t OFF_G = 224 * MiB;
constexpr size_t OFF_PO = 52 * MiB;
constexpr size_t OFF_XQ = 84 * MiB;
constexpr size_t OFF_HS = 232 * MiB;
constexpr size_t OFF_XR8 = 100 * MiB;
constexpr size_t OFF_XRS = 233 * MiB;
constexpr size_t OFF_WS8 = 32 * MiB;
constexpr size_t OFF_WSS = 34 * MiB;
constexpr size_t OFF_CHM = 37 * MiB;
constexpr size_t OFF_W28 = 35 * MiB;
constexpr size_t OFF_W2S = 36 * MiB;
constexpr size_t OFF_HN8 = 164 * MiB;
constexpr size_t OFF_WI8 = 180 * MiB;
constexpr size_t OFF_HSC = 184 * MiB;
constexpr size_t OFF_WSC = 184 * MiB + 65536;
constexpr size_t OFF_USC = 216 * MiB;
constexpr size_t WS_NEED = 256 * MiB;

constexpr int SMEM_BYTES = 151552;

struct Params { const float* in[21]; float* out; unsigned char* ws; int ph_lo, ph_hi; };
#define GPTR __attribute__((address_space(1)))
struct GParams { const GPTR float* in[21]; GPTR float* out; GPTR unsigned char* ws; int ph_lo, ph_hi; };
typedef const __attribute__((address_space(4))) GParams CParams;
#define PIN(k) ((const float*)p.in[k])
#define POUT ((float*)p.out)
#define PWS ((unsigned char*)p.ws)

typedef __bf16 bf16x2_t __attribute__((ext_vector_type(2)));
DEV unsigned pk2(float lo, float hi) { f32x2 v = {lo, hi}; bf16x2_t b = __builtin_convertvector(v, bf16x2_t); return __builtin_bit_cast(unsigned, b); }
DEV float bf_lo(unsigned u) { return __uint_as_float(u << 16); }
DEV float bf_hi(unsigned u) { return __uint_as_float(u & 0xffff0000u); }
DEV float bf2f(bf16_t b) { return __uint_as_float((unsigned)b << 16); }
DEV int img_off(int row, int kc, int rows) { return (kc * rows + (row ^ (kc & 3))) << 4; }
DEV float wave_sum(float v) {
#pragma unroll
    for (int o = 32; o; o >>= 1) v += __shfl_xor(v, o);
    return v;
}
DEV f32x4 mfma16(bf16x8 a, bf16x8 b, f32x4 c) { return __builtin_amdgcn_mfma_f32_16x16x32_bf16(a, b, c, 0, 0, 0); }
DEV bf16x8 neg8(bf16x8 v) { u32x4 u = __builtin_bit_cast(u32x4, v); u ^= 0x80008000u; return __builtin_bit_cast(bf16x8, u); }
template <class T> DEV T* opqp(T* p) { __attribute__((address_space(1))) T* g = (__attribute__((address_space(1))) T*)p; asm volatile("" : "+s"(g)); return (T*)g; }
DEV int opqs(int v) { asm volatile("" : "+s"(v)); return v; }
#define BID() opqs((int)blockIdx.x)
#define NBLK() opqs((int)gridDim.x)
DEV int opq(int v) { asm volatile("" : "+v"(v)); return v; }
DEV void lds_barrier() { asm volatile("s_waitcnt lgkmcnt(0)" ::: "memory"); __builtin_amdgcn_s_barrier(); asm volatile("" ::: "memory"); }
DEV float sigmoidf_(float x) { return 1.0f / (1.0f + __expf(-x)); }

template <int ROWS> struct RowLoader {
    static constexpr int NCH = ROWS * 8 / NT;
    const bf16_t* base; int ld; int tid;
    DEV void load(int t, u32x4* r) const {
#pragma unroll
        for (int i = 0; i < NCH; ++i) { const int c = tid + i * NT, row = c >> 3, kc = c & 7;
            r[i] = *(const u32x4*)(base + (size_t)row * ld + t * 64 + kc * 8); }
    }
    DEV void store(unsigned char* img, const u32x4* r) const {
        const int row = tid >> 3, kc = tid & 7;
        unsigned char* b = img + img_off(row, kc, ROWS);
#pragma unroll
        for (int i = 0; i < NCH; ++i) *(u32x4*)(b + i * 1024) = r[i];
    }
};
template <class LA, class LB>
DEV void gemm_core(const LA& la, const LB& lb, int ktiles, unsigned char* smem, f32x4 (&acc)[4][4]) {
    const int tid_ = la.tid; const int lane = tid_ & 63, w = tid_ >> 6, r = lane & 15, q = lane >> 4, wm = w >> 1, wn = w & 1;
    u32x4 ra[LA::NCH], rb[LB::NCH];
#pragma unroll
    for (int mi = 0; mi < 4; ++mi)
#pragma unroll
        for (int ni = 0; ni < 4; ++ni) acc[mi][ni] = (f32x4){0.f, 0.f, 0.f, 0.f};
    __syncthreads();
    la.load(0, ra); lb.load(0, rb);
    la.store(smem, ra); lb.store(smem + 32768, rb);
    __syncthreads();
    for (int t = 0; t < ktiles; ++t) {
        unsigned char* cur = smem + (t & 1) * 49152;
        unsigned char* nxt = smem + ((t + 1) & 1) * 49152;
        const bool more = t + 1 < ktiles;
        if (more) { la.load(t + 1, ra); lb.load(t + 1, rb); }
        const unsigned char* ca = cur + ((q * 256 + 64 * wm + (r ^ q)) << 4);
        const unsigned char* cb = cur + 32768 + ((q * 128 + 64 * wn + (r ^ q)) << 4);
#pragma unroll
        for (int s = 0; s < 2; ++s) {
            bf16x8 a[4], b[4];
#pragma unroll
            for (int mi = 0; mi < 4; ++mi) a[mi] = *(const bf16x8*)(ca + ((4 * s * 256 + 16 * mi) << 4));
#pragma unroll
            for (int ni = 0; ni < 4; ++ni) b[ni] = *(const bf16x8*)(cb + ((4 * s * 128 + 16 * ni) << 4));
#pragma unroll
            for (int mi = 0; mi < 4; ++mi)
#pragma unroll
                for (int ni = 0; ni < 4; ++ni) acc[mi][ni] = mfma16(a[mi], b[ni], acc[mi][ni]);
        }
        if (more) { la.store(nxt, ra); lb.store(nxt + 32768, rb); }
        __syncthreads();
    }
}

namespace pg8 {
#define PG8_LAS __attribute__((address_space(3)))
typedef unsigned short bf16_t;
typedef short bf16x8 __attribute__((ext_vector_type(8)));
typedef float f32x4 __attribute__((ext_vector_type(4)));
typedef unsigned u32x4 __attribute__((ext_vector_type(4)));
constexpr int BM = 256, BK = 64, HALF = 128, HTB = HALF * BK * 2  , STAGE_BYTES = 8 * HTB, NXCD = 8, WGM = 8;

__host__ __device__ __forceinline__ int lds_byte(int r, int c) { const int st = (r >> 4) * 2 + (c >> 5), rr = r & 15, cc = c & 31, ob = rr * 64 + cc * 2; return st * 1024 + (ob ^ (((ob >> 9) & 1) << 5)); }
__host__ __device__ __forceinline__ void stage_rc(int b, int& R, int& C) { const int st = b / 1024, sb = b % 1024, swz = sb ^ (((sb >> 9) & 1) << 5); R = (st >> 1) * 16 + swz / 64; C = (st & 1) * 32 + (swz % 64) / 2; }
__host__ __device__ __forceinline__ int perm32(int rho) { const int n = rho >> 4, i = rho & 15; return 8 * (i >> 2) + 4 * n + (i & 3); }

struct Unit { int pm, pn; };
template <int V> struct IC { static constexpr int value = V; };
struct Gemm { const bf16_t* A; const bf16_t* Bt; int M, N, K; };

struct StaticOrder {
    int nM, nN, nwg, G, c;
    __host__ __device__ void init(int M, int N, int G_, int c_) { nM = M / BM; nN = N / BM; nwg = nM * nN; G = G_; c = c_; }
    __host__ __device__ bool next(int i, Unit& u) const {
        const long L = (long)i * G + c; if (L >= nwg) return false;
        int wgid = (int)L; { const int q = nwg / NXCD, r = nwg % NXCD, xcd = wgid % NXCD, off = wgid / NXCD; wgid = (xcd < r ? xcd * (q + 1) : r * (q + 1) + (xcd - r) * q) + off; }
        const int nig = WGM * nN, gid = wgid / nig, fm = gid * WGM, gsz = (nM - fm) < WGM ? (nM - fm) : WGM;
        u.pm = fm + ((wgid % nig) % gsz); u.pn = (wgid % nig) / gsz; return true;
    }
    __device__ __forceinline__ void a_ready(const Unit&) const {}
    __device__ __forceinline__ void done(const Unit&) const {}
};

template <class Epi, class Sched, bool ALIGN_EPI = false, bool SP2 = false, int QM = 0, bool CH = false>
__device__ __forceinline__ void gemm_phase(PG8_LAS unsigned char* lds, const Gemm g, const Sched& S, const Epi& E, const Gemm g2 = Gemm{nullptr, nullptr, 0, 0, 0}) {
    const int tid = opq((int)threadIdx.x), wid = __builtin_amdgcn_readfirstlane(tid >> 6), lane = tid & 63, wr = wid >> 2, wc = wid & 3, fr = lane & 15, fq = lane >> 4;
    const int K = g.K, nt = K / BK;
    unsigned voffA[2], voffB[2];
#pragma unroll
    for (int i = 0; i < 2; ++i) { int R, C; stage_rc(tid * 16 + i * 8192, R, C); const int Rb = Epi::PERM ? ((R & ~31) + perm32(R & 31)) : R;
        voffA[i] = (unsigned)(R * K + C) * 2u; voffB[i] = (unsigned)(Rb * K + C) * 2u; }
    const size_t kstep = (size_t)(BK * 2);
    const size_t hstep = (size_t)HALF * K * 2;
    const size_t tstep = 2 * hstep;
    const unsigned ldsw = (unsigned)wid * 1024u;
    const int aoff = lds_byte(wr * 64 + fr, fq * 8), boff = lds_byte(wc * 32 + fr, fq * 8);
#define PG8_SA(b, h) (((b) * 2 + (h)) * HTB)
#define PG8_SB(b, h) ((4 + (b) * 2 + (h)) * HTB)
#define PG8_STAGE(bufoff, gbase, voff) do { _Pragma("unroll") for (int _i = 0; _i < 2; ++_i) \
        __builtin_amdgcn_global_load_lds((const unsigned*)((const char*)(gbase) + (voff)[_i]), (PG8_LAS unsigned*)(lds + (bufoff) + ldsw + _i * 8192), 16, 0, 0); } while (0)
#define PG8_LDA(dst, b, h) do { _Pragma("unroll") for (int m = 0; m < 4; ++m) _Pragma("unroll") for (int k = 0; k < 2; ++k) dst[m][k] = *(const PG8_LAS bf16x8*)(lds + PG8_SA(b, h) + aoff + m * 2048 + k * 1024); } while (0)
#define PG8_LDB(dst, b, h) do { _Pragma("unroll") for (int n = 0; n < 2; ++n) _Pragma("unroll") for (int k = 0; k < 2; ++k) dst[n][k] = *(const PG8_LAS bf16x8*)(lds + PG8_SB(b, h) + boff + n * 2048 + k * 1024); } while (0)
#define PG8_MMA(ai, bj, At, Bt) do { __builtin_amdgcn_s_setprio(1); _Pragma("unroll") for (int m = 0; m < 4; ++m) _Pragma("unroll") for (int n = 0; n < 2; ++n) _Pragma("unroll") for (int k = 0; k < 2; ++k) { \
        if constexpr (MQ == 2) { typedef int i4_t __attribute__((ext_vector_type(4))); \
            acc[ai][bj][m][n] = __builtin_bit_cast(f32x4, __builtin_amdgcn_mfma_i32_16x16x64_i8(__builtin_bit_cast(i4_t, Bt[n][k]), __builtin_bit_cast(i4_t, At[m][k]), __builtin_bit_cast(i4_t, acc[ai][bj][m][n]), 0, 0, 0)); } \
        else if constexpr (MQ == 1) { typedef long l2_t __attribute__((ext_vector_type(2))); const l2_t b8_ = __builtin_bit_cast(l2_t, Bt[n][k]), a8_ = __builtin_bit_cast(l2_t, At[m][k]); \
            acc[ai][bj][m][n] = __builtin_amdgcn_mfma_f32_16x16x32_fp8_fp8(b8_[0], a8_[0], acc[ai][bj][m][n], 0, 0, 0); acc[ai][bj][m][n] = __builtin_amdgcn_mfma_f32_16x16x32_fp8_fp8(b8_[1], a8_[1], acc[ai][bj][m][n], 0, 0, 0); } \
        else acc[ai][bj][m][n] = __builtin_amdgcn_mfma_f32_16x16x32_bf16(Bt[n][k], At[m][k], acc[ai][bj][m][n], 0, 0, 0); } __builtin_amdgcn_s_setprio(0); } while (0)
#define PG8_WAIT_V(n) asm volatile("s_waitcnt vmcnt(" #n ")" ::: "memory")
#define PG8_WAIT_L(n) asm volatile("s_waitcnt lgkmcnt(" #n ")" ::: "memory")
#define PG8_BAR __builtin_amdgcn_s_barrier()
#define PG8_SCHED __builtin_amdgcn_sched_barrier(0)
    Unit cur, nxt; int ui = 0;
    if (!S.next(0, cur)) return;
    f32x4 acc[2][2][4][2];
#pragma unroll
    for (int a = 0; a < 2; ++a)
#pragma unroll
        for (int b = 0; b < 2; ++b)
#pragma unroll
            for (int m = 0; m < 4; ++m)
#pragma unroll
                for (int n = 0; n < 2; ++n) acc[a][b][m][n] = (f32x4){0.f, 0.f, 0.f, 0.f};
    bf16x8 At[4][2], B0[2][2], B1[2][2];
    const char* cA = (const char*)g.A + (size_t)cur.pm * tstep; const char* cB = (const char*)g.Bt + (size_t)cur.pn * tstep;
    S.a_ready(cur);
    if constexpr (SP2) {
        PG8_STAGE(PG8_SB(0, 0), cB, voffB); PG8_STAGE(PG8_SB(0, 1), cB + hstep, voffB); PG8_STAGE(PG8_SA(0, 0), cA, voffA); PG8_STAGE(PG8_SA(0, 1), cA + hstep, voffA);
        if (wr == 1) PG8_BAR;
        PG8_WAIT_V(2); PG8_BAR;
        PG8_STAGE(PG8_SB(1, 0), cB + kstep, voffB); PG8_STAGE(PG8_SA(1, 0), cA + kstep, voffA); PG8_STAGE(PG8_SB(1, 1), cB + hstep + kstep, voffB);
        PG8_WAIT_V(6); PG8_BAR;
    } else {
        PG8_STAGE(PG8_SB(0, 0), cB, voffB); PG8_STAGE(PG8_SA(0, 0), cA, voffA); PG8_STAGE(PG8_SB(0, 1), cB + hstep, voffB); PG8_STAGE(PG8_SA(0, 1), cA + hstep, voffA);
        if (wr == 1) PG8_BAR;
        PG8_WAIT_V(4); PG8_BAR;
        PG8_STAGE(PG8_SB(1, 0), cB + kstep, voffB); PG8_STAGE(PG8_SA(1, 0), cA + kstep, voffA); PG8_STAGE(PG8_SB(1, 1), cB + hstep + kstep, voffB);
        PG8_WAIT_V(6); PG8_BAR;
    }
    for (;;) {
        const bool has_next = S.next(ui + 1, nxt);
        const char* nA = has_next ? (const char*)g.A + (size_t)nxt.pm * tstep : cA; const char* nB = has_next ? (const char*)g.Bt + (size_t)nxt.pn * tstep : cB;
        auto kloop = [&](auto tag, const char* nA, const char* nB) __attribute__((always_inline)) {
        constexpr int MQ = decltype(tag)::value;
        for (int t = 0; t < nt; t += 2) {
            const bool last = (t == nt - 2);
            const char* a1 = cA + (size_t)(t + 1) * kstep;
            const char* a2 = last ? nA : cA + (size_t)(t + 2) * kstep; const char* b2 = last ? nB : cB + (size_t)(t + 2) * kstep;
            const char* a3 = a2 + kstep; const char* b3 = b2 + kstep;
            if (last && has_next) S.a_ready(nxt);
            if constexpr (SP2) {
            PG8_LDB(B0, 0, 0); PG8_LDB(B1, 0, 1); PG8_SCHED; PG8_LDA(At, 0, 0); PG8_STAGE(PG8_SA(1, 1), a1 + hstep, voffA);
            PG8_WAIT_V(8); PG8_WAIT_L(0); PG8_BAR; PG8_MMA(0, 0, At, B0); PG8_MMA(0, 1, At, B1); PG8_BAR; PG8_SCHED;
            PG8_LDA(At, 0, 1); PG8_STAGE(PG8_SB(0, 0), b2, voffB); PG8_STAGE(PG8_SB(0, 1), b2 + hstep, voffB); PG8_STAGE(PG8_SA(0, 0), a2, voffA);
            PG8_WAIT_V(8); PG8_WAIT_L(0); PG8_BAR; PG8_MMA(1, 0, At, B0); PG8_MMA(1, 1, At, B1); PG8_BAR; PG8_SCHED;
            PG8_LDB(B0, 1, 0); PG8_LDB(B1, 1, 1); PG8_SCHED; PG8_LDA(At, 1, 0); PG8_STAGE(PG8_SA(0, 1), a2 + hstep, voffA);
            PG8_WAIT_V(8); PG8_WAIT_L(0); PG8_BAR; PG8_MMA(0, 0, At, B0); PG8_MMA(0, 1, At, B1); PG8_BAR; PG8_SCHED;
            PG8_LDA(At, 1, 1); PG8_STAGE(PG8_SB(1, 0), b3, voffB); PG8_STAGE(PG8_SB(1, 1), b3 + hstep, voffB); PG8_STAGE(PG8_SA(1, 0), a3, voffA);
            PG8_WAIT_V(8); PG8_WAIT_L(0); PG8_BAR; PG8_MMA(1, 0, At, B0); PG8_MMA(1, 1, At, B1); PG8_BAR; PG8_SCHED;
            } else {
            PG8_LDB(B0, 0, 0); PG8_SCHED; PG8_LDA(At, 0, 0); PG8_STAGE(PG8_SA(1, 1), a1 + hstep, voffA);
            PG8_WAIT_L(8); PG8_BAR; PG8_WAIT_L(0); PG8_MMA(0, 0, At, B0); PG8_BAR; PG8_SCHED;
            PG8_LDB(B1, 0, 1); PG8_STAGE(PG8_SB(0, 0), b2, voffB);
            PG8_BAR; PG8_WAIT_L(0); PG8_MMA(0, 1, At, B1); PG8_BAR;
            PG8_LDA(At, 0, 1); PG8_STAGE(PG8_SA(0, 0), a2, voffA);
            PG8_BAR; PG8_WAIT_L(0); PG8_MMA(1, 0, At, B0); PG8_BAR; PG8_SCHED;
            PG8_STAGE(PG8_SB(0, 1), b2 + hstep, voffB);
            PG8_WAIT_V(6); PG8_BAR; PG8_MMA(1, 1, At, B1); PG8_BAR;
            PG8_LDB(B0, 1, 0); PG8_SCHED; PG8_LDA(At, 1, 0); PG8_STAGE(PG8_SA(0, 1), a2 + hstep, voffA);
            PG8_WAIT_L(8); PG8_BAR; PG8_WAIT_L(0); PG8_MMA(0, 0, At, B0); PG8_BAR; PG8_SCHED;
            PG8_LDB(B1, 1, 1); PG8_STAGE(PG8_SB(1, 0), b3, voffB);
            PG8_BAR; PG8_WAIT_L(0); PG8_MMA(0, 1, At, B1); PG8_BAR;
            PG8_LDA(At, 1, 1); PG8_STAGE(PG8_SA(1, 0), a3, voffA);
            PG8_BAR; PG8_WAIT_L(0); PG8_MMA(1, 0, At, B0); PG8_BAR; PG8_SCHED;
            PG8_STAGE(PG8_SB(1, 1), b3 + hstep, voffB);
            PG8_WAIT_V(6); PG8_BAR; PG8_MMA(1, 1, At, B1); PG8_BAR;
            }
        }
        };
        if constexpr (CH) {
            const char* mA = (const char*)g2.A + (size_t)cur.pm * tstep; const char* mB = (const char*)g2.Bt + (size_t)cur.pn * tstep;
            kloop(IC<QM>{}, mA, mB);
            if constexpr (ALIGN_EPI) { if (wr == 0) PG8_BAR; }
            E.mid(acc, cur, wr, wc, fr, fq);
            cA = mA; cB = mB;
            if constexpr (ALIGN_EPI) { if (wr == 1) PG8_BAR; }
            kloop(IC<0>{}, nA, nB);
        } else kloop(IC<QM>{}, nA, nB);
        if constexpr (ALIGN_EPI) { if (wr == 0) PG8_BAR; }
        if constexpr (!Epi::AFTER_DRAIN) { E(acc, cur, wr, wc, fr, fq); S.done(cur); }
        if (!has_next) break;
#pragma unroll
        for (int a = 0; a < 2; ++a)
#pragma unroll
            for (int b = 0; b < 2; ++b)
#pragma unroll
                for (int m = 0; m < 4; ++m)
#pragma unroll
                    for (int n = 0; n < 2; ++n) acc[a][b][m][n] = (f32x4){0.f, 0.f, 0.f, 0.f};
        cur = nxt; cA = nA; cB = nB; ++ui;
        if constexpr (ALIGN_EPI) { if (wr == 1) PG8_BAR; }
    }
    PG8_WAIT_V(0);
    if constexpr (!ALIGN_EPI) { if (wr == 0) PG8_BAR; }
    PG8_BAR;
    if constexpr (Epi::AFTER_DRAIN) { E.fused(acc, cur, wr, wc, fr, fq, lds, wid, lane); S.done(cur); }
#undef PG8_SA
#undef PG8_SB
#undef PG8_STAGE
#undef PG8_LDA
#undef PG8_LDB
#undef PG8_MMA
#undef PG8_WAIT_V
#undef PG8_WAIT_L
#undef PG8_BAR
#undef PG8_SCHED
}
}

template <class F> struct Epi8 {
    static constexpr bool PERM = true, AFTER_DRAIN = false;
    F f;
    __device__ __forceinline__ void operator()(const pg8::f32x4 (&acc)[2][2][4][2], const pg8::Unit& u, int wr, int wc, int fr, int fq) const {
        fr = opq(fr); fq = opq(fq);
#pragma unroll
        for (int ai = 0; ai < 2; ++ai)
#pragma unroll
            for (int m = 0; m < 4; ++m) { const int row = u.pm * 256 + ai * 128 + wr * 64 + m * 16 + fr;
#pragma unroll
                for (int bj = 0; bj < 2; ++bj) { const int col0 = u.pn * 256 + bj * 128 + wc * 32 + 8 * fq; f(row, col0, acc[ai][bj][m][0], acc[ai][bj][m][1]); } }
    }
};
template <class L, class PRE, class POST, int NB> struct Epi8B {
    static constexpr bool PERM = true, AFTER_DRAIN = false;
    PRE pre; POST post;
    __device__ __forceinline__ void operator()(const pg8::f32x4 (&acc)[2][2][4][2], const pg8::Unit& u, int wr, int wc, int fr, int fq) const {
        fr = opq(fr); fq = opq(fq);
#pragma unroll
        for (int b0 = 0; b0 < 16; b0 += NB) {
            L ld[NB];
#pragma unroll
            for (int k = 0; k < NB; ++k) { const int fi = b0 + k, ai = fi >> 3, m = (fi >> 1) & 3, bj = fi & 1;
                ld[k] = pre(u.pm * 256 + ai * 128 + wr * 64 + m * 16 + fr, u.pn * 256 + bj * 128 + wc * 32 + 8 * fq); }
#pragma unroll
            for (int k = 0; k < NB; ++k) { const int fi = b0 + k, ai = fi >> 3, m = (fi >> 1) & 3, bj = fi & 1;
                post(u.pm * 256 + ai * 128 + wr * 64 + m * 16 + fr, u.pn * 256 + bj * 128 + wc * 32 + 8 * fq, acc[ai][bj][m][0], acc[ai][bj][m][1], ld[k]); }
        }
    }
};
template <class L, int NB, int QM = 0, class PRE, class POST> DEV void run_gemm_b(unsigned char* smem, const bf16_t* A, const bf16_t* Bt, int M, int N, int K, const PRE& pre, const POST& post) {
    A = opqp(A); Bt = opqp(Bt);
    pg8::Gemm g{A, Bt, M, N, K};
    pg8::StaticOrder S; S.init(M, N, (int)NBLK(), (int)BID());
    Epi8B<L, PRE, POST, NB> E{pre, post};
    __syncthreads();
    pg8::gemm_phase<Epi8B<L, PRE, POST, NB>, pg8::StaticOrder, true, true, QM>((PG8_LAS unsigned char*)smem, g, S, E);
    __syncthreads();
}
template <class LM, class MPRE, class MPOST, int NBM, class L, class PRE, class POST, int NB> struct Epi8C {
    static constexpr bool PERM = true, AFTER_DRAIN = false;
    MPRE mpre; MPOST mpost; PRE pre; POST post;
    __device__ __forceinline__ void mid(pg8::f32x4 (&acc)[2][2][4][2], const pg8::Unit& u, int wr, int wc, int fr, int fq) const {
        fr = opq(fr); fq = opq(fq);
#pragma unroll
        for (int b0 = 0; b0 < 16; b0 += NBM) {
            LM ld[NBM];
#pragma unroll
            for (int k = 0; k < NBM; ++k) { const int fi = b0 + k, ai = fi >> 3, m = (fi >> 1) & 3, bj = fi & 1;
                ld[k] = mpre(u.pm * 256 + ai * 128 + wr * 64 + m * 16 + fr, u.pn * 256 + bj * 128 + wc * 32 + 8 * fq); }
#pragma unroll
            for (int k = 0; k < NBM; ++k) { const int fi = b0 + k, ai = fi >> 3, m = (fi >> 1) & 3, bj = fi & 1;
                mpost(acc[ai][bj][m][0], acc[ai][bj][m][1], ld[k]); }
        }
    }
    __device__ __forceinline__ void operator()(const pg8::f32x4 (&acc)[2][2][4][2], const pg8::Unit& u, int wr, int wc, int fr, int fq) const {
        fr = opq(fr); fq = opq(fq);
#pragma unroll
        for (int b0 = 0; b0 < 16; b0 += NB) {
            L ld[NB];
#pragma unroll
            for (int k = 0; k < NB; ++k) { const int fi = b0 + k, ai = fi >> 3, m = (fi >> 1) & 3, bj = fi & 1;
                ld[k] = pre(u.pm * 256 + ai * 128 + wr * 64 + m * 16 + fr, u.pn * 256 + bj * 128 + wc * 32 + 8 * fq); }
#pragma unroll
            for (int k = 0; k < NB; ++k) { const int fi = b0 + k, ai = fi >> 3, m = (fi >> 1) & 3, bj = fi & 1;
                post(u.pm * 256 + ai * 128 + wr * 64 + m * 16 + fr, u.pn * 256 + bj * 128 + wc * 32 + 8 * fq, acc[ai][bj][m][0], acc[ai][bj][m][1], ld[k]); }
        }
    }
};
template <class LM, int NBM, class L, int NB, int QM, class MPRE, class MPOST, class PRE, class POST>
DEV void run_gemm_chain(unsigned char* smem, const bf16_t* A, const bf16_t* Bt, const bf16_t* A2, const bf16_t* Bt2, int M, int N, int K, const MPRE& mpre, const MPOST& mpost, const PRE& pre, const POST& post) {
    A = opqp(A); Bt = opqp(Bt); A2 = opqp(A2); Bt2 = opqp(Bt2);
    pg8::Gemm g{A, Bt, M, N, K}, g2{A2, Bt2, M, N, K};
    pg8::StaticOrder S; S.init(M, N, (int)NBLK(), (int)BID());
    typedef Epi8C<LM, MPRE, MPOST, NBM, L, PRE, POST, NB> E_t;
    E_t E{mpre, mpost, pre, post};
    __syncthreads();
    pg8::gemm_phase<E_t, pg8::StaticOrder, true, true, QM, true>((PG8_LAS unsigned char*)smem, g, S, E, g2);
    __syncthreads();
}
struct L1f { float a; }; struct L2q { f32x4 a, b; }; struct L1u { u32x4 a; }; struct L2u { u32x4 a, b; }; struct L1d { unsigned long long a; };
template <class F> DEV void run_gemm(unsigned char* smem, const bf16_t* A, const bf16_t* Bt, int M, int N, int K, const F& f) {
    A = opqp(A); Bt = opqp(Bt);
    pg8::Gemm g{A, Bt, M, N, K};
    pg8::StaticOrder S; S.init(M, N, (int)NBLK(), (int)BID());
    Epi8<F> E{f};
    __syncthreads();
    pg8::gemm_phase<Epi8<F>, pg8::StaticOrder, true, true>((PG8_LAS unsigned char*)smem, g, S, E);
    __syncthreads();
}
DEV u32x4 pack8v(f32x4 a, f32x4 b) { u32x4 o; o.x = pk2(a[0], a[1]); o.y = pk2(a[2], a[3]); o.z = pk2(b[0], b[1]); o.w = pk2(b[2], b[3]); return o; }
DEV void unpack8v(u32x4 v, f32x4& a, f32x4& b) { a = (f32x4){bf_lo(v.x), bf_hi(v.x), bf_lo(v.y), bf_hi(v.y)}; b = (f32x4){bf_lo(v.z), bf_hi(v.z), bf_lo(v.w), bf_hi(v.w)}; }

DEV unsigned pack_i8x4(float a, float b, float c, float d, float sc);
DEV void rms_rows4(const float* __restrict__ src, const float* __restrict__ g, unsigned* __restrict__ dst8, float* __restrict__ dsc, int row0, int lane) {
    f32x4 v[4][4]; float ss[4];
    const float eps_ = __int_as_float(opq(__float_as_int(1e-6f)));

#pragma unroll
    for (int k = 0; k < 4; ++k)
#pragma unroll
        for (int i = 0; i < 4; ++i) v[k][i] = *(const f32x4*)(src + (size_t)(row0 + k) * 1024 + 4 * lane + 256 * i);
#pragma unroll
    for (int k = 0; k < 4; ++k) { ss[k] = 0.f;
#pragma unroll
        for (int i = 0; i < 4; ++i) ss[k] += v[k][i][0] * v[k][i][0] + v[k][i][1] * v[k][i][1] + v[k][i][2] * v[k][i][2] + v[k][i][3] * v[k][i][3]; }
#pragma unroll
    for (int o = 32; o; o >>= 1) {
#pragma unroll
        for (int k = 0; k < 4; ++k) ss[k] += __shfl_xor(ss[k], o); }
    float am[4] = {0.f, 0.f, 0.f, 0.f};
#pragma unroll
    for (int i = 0; i < 4; ++i) { const f32x4 gg = *(const f32x4*)(g + 4 * lane + 256 * i);
#pragma unroll
        for (int k = 0; k < 4; ++k) { const float sc = rsqrtf(ss[k] * (1.0f / 1024.0f) + eps_); v[k][i] = v[k][i] * sc * gg;
            am[k] = fmaxf(am[k], fmaxf(fmaxf(fabsf(v[k][i][0]), fabsf(v[k][i][1])), fmaxf(fabsf(v[k][i][2]), fabsf(v[k][i][3])))); } }
#pragma unroll
    for (int o = 32; o; o >>= 1) {
#pragma unroll
        for (int k = 0; k < 4; ++k) am[k] = fmaxf(am[k], __shfl_xor(am[k], o)); }
#pragma unroll
    for (int k = 0; k < 4; ++k) { const float inv = am[k] > 0.f ? 127.0f / am[k] : 0.f;
#pragma unroll
        for (int i = 0; i < 4; ++i) dst8[(size_t)(row0 + k) * 256 + lane + 64 * i] = pack_i8x4(v[k][i][0], v[k][i][1], v[k][i][2], v[k][i][3], inv);
        if (lane == 0) dsc[row0 + k] = am[k] * (1.0f / 127.0f); }
}
DEV void transpose_tile(const float* __restrict__ src, int R, int C, int r0, int c0, bf16_t* __restrict__ dst, float* tile, const float* __restrict__ rgain = nullptr) {
    const int tq = opq((int)threadIdx.x); const int tx = tq & 63, ty = tq >> 6;
    __syncthreads();
#pragma unroll
    for (int i = 0; i < 8; ++i) { const int rr = ty + 8 * i; tile[rr * 65 + tx] = src[(size_t)(r0 + rr) * C + c0 + tx] * (rgain ? rgain[r0 + rr] : 1.0f); }
    __syncthreads();
#pragma unroll
    for (int i = 0; i < 8; ++i) { const int cc = ty + 8 * i; dst[(size_t)(c0 + cc) * R + r0 + tx] = (bf16_t)(pk2(tile[tx * 65 + cc], 0.f) & 0xffffu); }
}
DEV void cvt_stream(const float* __restrict__ src, bf16_t* __restrict__ dst, size_t n4) {
    for (size_t i = (size_t)BID() * NT + opq((int)threadIdx.x); i < n4; i += (size_t)NBLK() * NT) {
        const f32x4 v = *(const f32x4*)(src + 4 * i); u32x2 o; o.x = pk2(v[0], v[1]); o.y = pk2(v[2], v[3]); *(u32x2*)(dst + 4 * i) = o; }
}


DEV unsigned pack_i8x4(float a, float b, float c, float d, float sc) {
    const unsigned q0 = __float_as_uint(fmaf(a, sc, 12582912.0f)), q1 = __float_as_uint(fmaf(b, sc, 12582912.0f)), q2 = __float_as_uint(fmaf(c, sc, 12582912.0f)), q3 = __float_as_uint(fmaf(d, sc, 12582912.0f));
    const unsigned p01 = __builtin_amdgcn_perm(q1, q0, 0x0c0c0400u), p23 = __builtin_amdgcn_perm(q3, q2, 0x0c0c0400u);
    return __builtin_amdgcn_perm(p23, p01, 0x05040100u);
}
DEV void cvt8_rows(const float* __restrict__ src, unsigned* __restrict__ dst8, float* __restrict__ scale, int lane, int wave, const float* __restrict__ cgain = nullptr, bool i8 = false) {
    for (int row0 = (BID() * 8 + wave) * 4; row0 < 16384; row0 += NBLK() * 32) {
        f32x4 v[4][4]; float am[4];
#pragma unroll
        for (int k = 0; k < 4; ++k)
#pragma unroll
            for (int i = 0; i < 4; ++i) { v[k][i] = *(const f32x4*)(src + (size_t)(row0 + k) * 1024 + 4 * lane + 256 * i); if (cgain) v[k][i] = v[k][i] * *(const f32x4*)(cgain + 4 * lane + 256 * i); }
#pragma unroll
        for (int k = 0; k < 4; ++k) { am[k] = 0.f;
#pragma unroll
            for (int i = 0; i < 4; ++i) am[k] = fmaxf(am[k], fmaxf(fmaxf(fabsf(v[k][i][0]), fabsf(v[k][i][1])), fmaxf(fabsf(v[k][i][2]), fabsf(v[k][i][3])))); }
#pragma unroll
        for (int o = 32; o; o >>= 1) {
#pragma unroll
            for (int k = 0; k < 4; ++k) am[k] = fmaxf(am[k], __shfl_xor(am[k], o)); }
#pragma unroll
        for (int k = 0; k < 4; ++k) { const float top = i8 ? 127.0f : 256.0f; const float sc = am[k] > 0.f ? top / am[k] : 1.0f;
#pragma unroll
            for (int i = 0; i < 4; ++i) { int pk;
                if (i8) pk = (int)pack_i8x4(v[k][i][0], v[k][i][1], v[k][i][2], v[k][i][3], sc);
                else { pk = __builtin_amdgcn_cvt_pk_fp8_f32(v[k][i][0] * sc, v[k][i][1] * sc, 0, false); pk = __builtin_amdgcn_cvt_pk_fp8_f32(v[k][i][2] * sc, v[k][i][3] * sc, pk, true); }
                dst8[((size_t)(2 * i + (lane >> 5)) * 16384 + row0 + k) * 32 + (lane & 31)] = (unsigned)pk; }
            if (lane == 0) scale[row0 + k] = am[k] > 0.f ? am[k] / top : 1.0f; }
    }
}

DEV void cv_finish(f32x4 (&cv)[2][4], unsigned* __restrict__ dst8, float* __restrict__ scale, const float* __restrict__ cgain, int row0, int lane, bool i8) {
#pragma unroll
    for (int k = 0; k < 2; ++k) {
        float am = 0.f;
#pragma unroll
        for (int i = 0; i < 4; ++i) { if (cgain) cv[k][i] = cv[k][i] * *(const f32x4*)(cgain + 4 * lane + 256 * i);
            am = fmaxf(am, fmaxf(fmaxf(fabsf(cv[k][i][0]), fabsf(cv[k][i][1])), fmaxf(fabsf(cv[k][i][2]), fabsf(cv[k][i][3])))); }
#pragma unroll
        for (int o = 32; o; o >>= 1) am = fmaxf(am, __shfl_xor(am, o));
        const float top = i8 ? 127.0f : 256.0f; const float sc = am > 0.f ? top / am : 1.0f;
#pragma unroll
        for (int i = 0; i < 4; ++i) { int pk;
            if (i8) pk = (int)pack_i8x4(cv[k][i][0], cv[k][i][1], cv[k][i][2], cv[k][i][3], sc);
            else { pk = __builtin_amdgcn_cvt_pk_fp8_f32(cv[k][i][0] * sc, cv[k][i][1] * sc, 0, false); pk = __builtin_amdgcn_cvt_pk_fp8_f32(cv[k][i][2] * sc, cv[k][i][3] * sc, pk, true); }
            dst8[((size_t)(2 * i + (lane >> 5)) * 16384 + row0 + k) * 32 + (lane & 31)] = (unsigned)pk; }
        if (lane == 0) scale[row0 + k] = am > 0.f ? am / top : 1.0f;
    }
}

DEV void fold_ws_tile(CParams& p, int i) {
    const int tid = opq((int)threadIdx.x), lane = tid & 63, w = tid >> 6, r = lane & 15, q = lane >> 4;
    unsigned char* ws = opqp(PWS);
    const float* wq = PIN(16); const float* keysf = PIN(17); const float* gn = PIN(15); bf16_t* wst = (bf16_t*)(ws + OFF_WQ);
    const int hc = i >> 5, n0 = ((i >> 4) & 1) * 64, K0 = (i & 15) * 64, mt = w & 3, nt0 = 2 * (w >> 2);
    const int Kr = K0 + 16 * mt + r; const float gk = gn[Kr];
    bf16x8 a[4], b[2][4];
#pragma unroll
    for (int s = 0; s < 4; ++s) { const float* pa = wq + (size_t)Kr * 2048 + hc * 128 + 32 * s + 8 * q; const f32x4 a0 = *(const f32x4*)pa * gk, a1 = *(const f32x4*)(pa + 4) * gk;
        u32x4 o; o.x = pk2(a0[0], a0[1]); o.y = pk2(a0[2], a0[3]); o.z = pk2(a1[0], a1[1]); o.w = pk2(a1[2], a1[3]); a[s] = __builtin_bit_cast(bf16x8, o);
#pragma unroll
        for (int t = 0; t < 2; ++t) { const float* pb = keysf + ((size_t)hc * 128 + n0 + 16 * (nt0 + t) + r) * 128 + 32 * s + 8 * q; const f32x4 b0 = *(const f32x4*)pb, b1 = *(const f32x4*)(pb + 4);
            u32x4 ob; ob.x = pk2(b0[0], b0[1]); ob.y = pk2(b0[2], b0[3]); ob.z = pk2(b1[0], b1[1]); ob.w = pk2(b1[2], b1[3]); b[t][s] = __builtin_bit_cast(bf16x8, ob); } }
#pragma unroll
    for (int t = 0; t < 2; ++t) { f32x4 acc = {0.f, 0.f, 0.f, 0.f};
#pragma unroll
        for (int s = 0; s < 4; ++s) acc = mfma16(a[s], b[t][s], acc);
        u32x2 o; o.x = pk2(acc[0], acc[1]); o.y = pk2(acc[2], acc[3]);
        *(u32x2*)(wst + ((size_t)hc * 128 + n0 + 16 * (nt0 + t) + r) * 1024 + K0 + 16 * mt + 4 * q) = o; }
}
DEV void quant_w_in_slab(CParams& p, unsigned char* smem, int s) {
    const int tid = opq((int)threadIdx.x), lane = tid & 63, w = tid >> 6, col4 = tid & 3, r0 = tid >> 2;
    unsigned char* ws = opqp(PWS);
    const float* win = PIN(2); unsigned char* wi8 = ws + OFF_WI8; float* wsc = (float*)(ws + OFF_WSC);
    float* red = (float*)smem; unsigned char* l8 = smem + 1024;
    const int c0 = 16 * s;
    f32x4 v[8];
#pragma unroll
    for (int j = 0; j < 8; ++j) v[j] = *(const f32x4*)(win + (size_t)(r0 + 128 * j) * 4096 + c0 + 4 * col4);
    f32x4 m = {0.f, 0.f, 0.f, 0.f};
#pragma unroll
    for (int j = 0; j < 8; ++j)
#pragma unroll
        for (int k = 0; k < 4; ++k) m[k] = fmaxf(m[k], fabsf(v[j][k]));
#pragma unroll
    for (int o = 4; o < 64; o <<= 1)
#pragma unroll
        for (int k = 0; k < 4; ++k) m[k] = fmaxf(m[k], __shfl_xor(m[k], o));
    __syncthreads();
    if (lane < 4) *(f32x4*)(red + w * 16 + 4 * lane) = m;
    __syncthreads();
    f32x4 cm = {0.f, 0.f, 0.f, 0.f};
#pragma unroll
    for (int ww = 0; ww < 8; ++ww) { const f32x4 t = *(const f32x4*)(red + ww * 16 + 4 * col4);
#pragma unroll
        for (int k = 0; k < 4; ++k) cm[k] = fmaxf(cm[k], t[k]); }
    f32x4 inv;
#pragma unroll
    for (int k = 0; k < 4; ++k) inv[k] = cm[k] > 0.f ? 127.0f / cm[k] : 0.f;
    if (tid < 4) *(f32x4*)(wsc + c0 + 4 * col4) = cm * (1.0f / 127.0f);
#pragma unroll
    for (int j = 0; j < 8; ++j)
#pragma unroll
        for (int k = 0; k < 4; ++k) l8[(4 * col4 + k) * 1040 + r0 + 128 * j] = (unsigned char)__float_as_uint(fmaf(v[j][k], inv[k], 12582912.0f));
    __syncthreads();
#pragma unroll
    for (int i = 0; i < 2; ++i) { const int pc = tid + i * NT, col = pc >> 6, off = (pc & 63) * 16;
        *(u32x4*)(wi8 + (size_t)(c0 + col) * 1024 + off) = *(const u32x4*)(l8 + col * 1040 + off); }
}
DEV void phase0(CParams& p, unsigned char* smem) {
    const int tid = opq((int)threadIdx.x), lane = tid & 63, wave = tid >> 6, nb = NBLK(), bid = BID();
    unsigned char* ws = opqp(PWS);
    for (int row = (bid * 8 + wave) * 4; row < T_; row += nb * 32) rms_rows4(PIN(0), PIN(1), (unsigned*)(ws + OFF_HN8), (float*)(ws + OFF_HSC), row, lane);
    {
        const int tx = tid & 63, ty = tid >> 6;
        for (int i = bid; i < 512; i += nb) fold_ws_tile(p, i);
        for (int s = bid; s < 256; s += nb) quant_w_in_slab(p, smem, s);
        for (int i0 = 1536 + bid; i0 < 2080; i0 += 4 * nb) {
            float tv[4][8];
            __syncthreads();
#pragma unroll
            for (int b = 0; b < 4; ++b) { const int i = i0 + b * nb;
                if (i < 2080 && i >= 1536) {
                    const float* src; int R, C, ti; const float* rg = nullptr;
                    if (i < 1024) { src = PIN(2); R = 1024; C = 4096; ti = i; }
                    else if (i < 1536) { src = PIN(16); R = 1024; C = 2048; ti = i - 1024; rg = PIN(15); }
                    else if (i < 1792) { src = PIN(14); R = 1024; C = 1024; ti = i - 1536; }
                    else if (i < 1920) { src = PIN(12); R = 512; C = 1024; ti = i - 1792; }
                    else if (i < 2048) { src = PIN(13); R = 512; C = 1024; ti = i - 1920; }
                    else { src = PIN(10); R = 64; C = 2048; ti = i - 2048; }
                    const int tc = C / 64, r0 = (ti / tc) * 64, c0 = (ti % tc) * 64;
#pragma unroll
                    for (int k = 0; k < 8; ++k) { const int rr = ty + 8 * k; tv[b][k] = src[(size_t)(r0 + rr) * C + c0 + tx] * (rg ? rg[r0 + rr] : 1.0f); }
                } }
#pragma unroll
            for (int b = 0; b < 4; ++b) { float* tile = (float*)smem + b * (64 * 65);
                if (i0 + b * nb < 2080 && i0 + b * nb >= 1536) {
#pragma unroll
                    for (int k = 0; k < 8; ++k) tile[(ty + 8 * k) * 65 + tx] = tv[b][k]; } }
            __syncthreads();
#pragma unroll
            for (int b = 0; b < 4; ++b) { const int i = i0 + b * nb;
                if (i < 2080 && i >= 1536) {
                    bf16_t* dst; int R, C, ti;
                    if (i < 1024) { dst = (bf16_t*)(ws + OFF_WIN); R = 1024; C = 4096; ti = i; }
                    else if (i < 1536) { dst = (bf16_t*)(ws + OFF_WQ); R = 1024; C = 2048; ti = i - 1024; }
                    else if (i < 1792) { dst = (bf16_t*)(ws + OFF_WOUT); R = 1024; C = 1024; ti = i - 1536; }
                    else if (i < 1920) { dst = (bf16_t*)(ws + OFF_WHY); R = 512; C = 1024; ti = i - 1792; }
                    else if (i < 2048) { dst = (bf16_t*)(ws + OFF_WFN); R = 512; C = 1024; ti = i - 1920; }
                    else { dst = (bf16_t*)(ws + OFF_W3); R = 64; C = 2048; ti = i - 2048; }
                    const int tc = C / 64, r0 = (ti / tc) * 64, c0 = (ti % tc) * 64;
                    const float* tile = (const float*)smem + b * (64 * 65);
#pragma unroll
                    for (int k = 0; k < 8; ++k) { const int cc = ty + 8 * k; dst[(size_t)(c0 + cc) * R + r0 + tx] = (bf16_t)(pk2(tile[tx * 65 + cc], 0.f) & 0xffffu); }
                } }
        }
        __syncthreads();
    }
    for (int i = bid * NT + tid; i < T_; i += nb * NT) ((unsigned long long*)(ws + OFF_SS1))[i] = 0ull;
    if (NBLK() != 256) cvt8_rows(PIN(18), (unsigned*)(ws + OFF_U), (float*)(ws + OFF_US), lane, wave, PIN(15), true);
    {
        const float* w1 = PIN(6); const float* b1 = PIN(7); const float* w2 = PIN(8); const float* b2 = PIN(9);
        bf16_t* hd = (bf16_t*)(ws + OFF_HDN2);
        float w1c[33], w2c[64];
#pragma unroll
        for (int i = 0; i < 33; ++i) w1c[i] = w1[i * 64 + lane];
#pragma unroll
        for (int i = 0; i < 64; ++i) w2c[i] = w2[i * 64 + lane];
        const float b1v = b1[lane], b2v = b2[lane];
        const float b0_ = __int_as_float(opq(__float_as_int(1e-4f)));
        const int lstep = nb * 8;
        for (int l = bid * 8 + wave; l < L_; l += lstep) {
            const float tpos = (float)l / 8191.0f, rev = (float)l * (1.0f / 8192.0f);
            float z = 0.f;
            if (lane == 0) z = tpos;
            if (lane >= 1 && lane <= 16) { const float band = b0_ + (float)(lane - 1) * ((15.0f - 1e-4f) / 15.0f); z = __builtin_amdgcn_cosf(__builtin_amdgcn_fractf(band * rev)); }
            else if (lane >= 17 && lane <= 32) { const float band = b0_ + (float)(lane - 17) * ((15.0f - 1e-4f) / 15.0f); z = -__builtin_amdgcn_sinf(__builtin_amdgcn_fractf(band * rev)); }
            float a = b1v;
#pragma unroll
            for (int i = 0; i < 33; ++i) a += __shfl(z, i) * w1c[i];
            const float h1 = __builtin_amdgcn_sinf(__builtin_amdgcn_fractf(a * 0.15915494309189535f));
            float c = b2v;
#pragma unroll
            for (int i = 0; i < 64; ++i) c += __shfl(h1, i) * w2c[i];
            const float h2 = __builtin_amdgcn_sinf(__builtin_amdgcn_fractf(c * 0.15915494309189535f));
            hd[l * 64 + lane] = (bf16_t)(pk2(h2, 0.f) & 0xffffu);
        }
    }
    {
        bf16_t* dt = (bf16_t*)(ws + OFF_DT);
        unsigned char* tab = ws + OFF_TAB;
        for (int i = bid * NT + tid; i < 32768; i += nb * NT) {
            const int row = i >> 7, j = i & 127, c = row & 127, plane = row >> 7;
            const float x = (float)((c * j) & 127) * (1.0f / 64.0f);
            const float cv = cospif(x), sv = sinpif(x);
            dt[i] = (bf16_t)(pk2((plane ? sv : cv) * (1.0f / 1024.0f), 0.f) & 0xffffu);
            const int r128 = c, k = j;
            const int off = img_off(r128, k >> 3, 128) + (k & 7) * 2;
            *(bf16_t*)(tab + plane * 32768 + off) = (bf16_t)(pk2(plane ? sv : cv, 0.f) & 0xffffu);
        }
    }
}

DEV void phase1(CParams& p, unsigned char* smem) {
    const int tid = opq((int)threadIdx.x); const int lane = tid & 63, w = tid >> 6, r = lane & 15, q = lane >> 4, wm = w >> 1, wn = w & 1;
    unsigned char* ws = opqp(PWS);
    const bf16_t* hn = (const bf16_t*)(ws + OFF_HN);
    const bf16_t* w_in_t = (const bf16_t*)(ws + OFF_WIN);
    const float* b_in = PIN(3);
    const float* hsc = (const float*)(ws + OFF_HSC); const float* wsc = (const float*)(ws + OFF_WSC);
    const bf16_t* hq = (const bf16_t*)(ws + OFF_HN8); const bf16_t* wq8 = (const bf16_t*)(ws + OFF_WI8);
    typedef int i32x4_t __attribute__((ext_vector_type(4)));
    {
        bf16_t* pT = (bf16_t*)(ws + OFF_PT);
        struct LA { float b, s; f32x4 h0, h1; };
        auto pre = [=](int row, int col0) { LA l; l.b = b_in[row]; l.s = wsc[row]; l.h0 = *(const f32x4*)(hsc + col0); l.h1 = *(const f32x4*)(hsc + col0 + 4); return l; };
        auto post = [=](int row, int col0, f32x4 v0, f32x4 v1, const LA& l) { const i32x4_t i0 = __builtin_bit_cast(i32x4_t, v0), i1 = __builtin_bit_cast(i32x4_t, v1);
            const f32x4 f0 = __builtin_convertvector(i0, f32x4) * l.s * l.h0 + l.b, f1 = __builtin_convertvector(i1, f32x4) * l.s * l.h1 + l.b;
            *(u32x4*)(pT + (size_t)row * T_ + col0) = pack8v(f0, f1); };
        run_gemm_b<LA, 8, 2>(smem, wq8, hq, 2048, T_, 512, pre, post);
    }
    {
        bf16_t* sg = (bf16_t*)POUT;
        struct LB { float h; f32x4 s0, s1, b0, b1; };
        auto pre = [=](int row, int col0) { LB l; l.h = hsc[row]; l.s0 = *(const f32x4*)(wsc + 2048 + col0); l.s1 = *(const f32x4*)(wsc + 2048 + col0 + 4); l.b0 = *(const f32x4*)(b_in + 2048 + col0); l.b1 = *(const f32x4*)(b_in + 2048 + col0 + 4); return l; };
        auto post = [=](int row, int col0, f32x4 v0, f32x4 v1, const LB& l) { const i32x4_t i0 = __builtin_bit_cast(i32x4_t, v0), i1 = __builtin_bit_cast(i32x4_t, v1);
            f32x4 a = __builtin_convertvector(i0, f32x4) * l.h * l.s0 + l.b0, b = __builtin_convertvector(i1, f32x4) * l.h * l.s1 + l.b1;
#pragma unroll
            for (int k = 0; k < 4; ++k) { a[k] = sigmoidf_(a[k]); b[k] = sigmoidf_(b[k]); }
            *(u32x4*)(sg + (size_t)row * 2048 + col0) = pack8v(a, b); };
        run_gemm_b<LB, 4, 2>(smem, hq, wq8 + (size_t)2048 * 512, T_, 2048, 512, pre, post);
    }
    {
        const bf16_t* wst = (const bf16_t*)(ws + OFF_WQ); unsigned* ws8 = (unsigned*)(ws + OFF_WS8); float* wss = (float*)(ws + OFF_WSS);
        const int rstep_ = NBLK() * 8;
        for (int f = BID() * 8 + w; f < 2048; f += rstep_) {
            const u32x4 r0_ = *(const u32x4*)(wst + (size_t)f * 1024 + 16 * lane), r1_ = *(const u32x4*)(wst + (size_t)f * 1024 + 16 * lane + 8);
            f32x4 a0, a1, a2, a3; unpack8v(r0_, a0, a1); unpack8v(r1_, a2, a3);
            float am = 0.f;
#pragma unroll
            for (int k = 0; k < 4; ++k) am = fmaxf(am, fmaxf(fmaxf(fabsf(a0[k]), fabsf(a1[k])), fmaxf(fabsf(a2[k]), fabsf(a3[k]))));
#pragma unroll
            for (int o = 32; o; o >>= 1) am = fmaxf(am, __shfl_xor(am, o));
            const float inv = am > 0.f ? 127.0f / am : 0.f;
            u32x4 qv; qv.x = pack_i8x4(a0[0], a0[1], a0[2], a0[3], inv); qv.y = pack_i8x4(a1[0], a1[1], a1[2], a1[3], inv); qv.z = pack_i8x4(a2[0], a2[1], a2[2], a2[3], inv); qv.w = pack_i8x4(a3[0], a3[1], a3[2], a3[3], inv);
            *(u32x4*)(ws8 + (size_t)f * 256 + 4 * lane) = qv;
            if (lane == 0) wss[f] = am * (1.0f / 127.0f);
        }
    }
    const int iend_ = NBLK() == 256 ? 2560 : 2592;
    for (int i = BID() + 2048; i < iend_; i += NBLK()) {
        f32x4 acc[4][4];
        if (i < 2560) {
            const int i3 = i - 2048, tm = i3 >> 4, tn = i3 & 15;
            RowLoader<256> la{(const bf16_t*)(ws + OFF_HDN2) + (size_t)tm * 256 * 64, 64, tid}; RowLoader<128> lb{(const bf16_t*)(ws + OFF_W3) + (size_t)tn * 128 * 64, 64, tid};
            gemm_core(la, lb, 1, smem, acc);
            bf16_t* hf = (bf16_t*)(ws + OFF_HF);
            const float min_decay = -3.0701134573253946f, max_decay = -15.350567286626973f;
#pragma unroll
            for (int ni = 0; ni < 4; ++ni) { const int col = 128 * tn + 64 * wn + 16 * ni + r, c = col & 511;
                const float delta = fabsf(min_decay + (float)c * ((max_decay - min_decay) / 511.0f));
#pragma unroll
                for (int mi = 0; mi < 4; ++mi) { const int l = 256 * tm + 64 * wm + 16 * mi + 4 * q; const f32x4 v = acc[mi][ni];
                    float e[4];
#pragma unroll
                    for (int k = 0; k < 4; ++k) e[k] = v[k] * __expf(-((float)(l + k) * (1.0f / 8191.0f)) * delta);
                    u32x2 o; o.x = pk2(e[0], e[1]); o.y = pk2(e[2], e[3]);
                    *(u32x2*)(smem + (64 * wn + 16 * ni + r) * 528 + (64 * wm + 16 * mi + 4 * q) * 2) = o; } }
            __syncthreads();
#pragma unroll
            for (int it = 0; it < 8; ++it) { const int pc = tid + it * NT, cl = pc >> 5, piece = pc & 31;
                *(u32x4*)(hf + (size_t)(128 * tn + cl) * L_ + 256 * tm + piece * 8) = *(const u32x4*)(smem + cl * 528 + piece * 16); }
        } else {
            const int i4 = i - 2560, g = i4 >> 3, tn = i4 & 7;
            RowLoader<256> la{(const bf16_t*)(ws + OFF_DT), 128, tid}; RowLoader<128> lb{(const bf16_t*)(ws + OFF_WFN) + (size_t)tn * 128 * 512 + g * 128, 512, tid};
            gemm_core(la, lb, 2, smem, acc);
            bf16_t* w2 = (bf16_t*)(ws + OFF_W2);
#pragma unroll
            for (int ni = 0; ni < 4; ++ni) { const int n = 128 * tn + 64 * wn + 16 * ni + r;
#pragma unroll
                for (int mi = 0; mi < 4; ++mi) { const int mm = 64 * wm + 16 * mi + 4 * q, plane = mm >> 7, c = mm & 127; const f32x4 v = acc[mi][ni];
                    u32x2 o; o.x = pk2(v[0], v[1]); o.y = pk2(v[2], v[3]);
                    *(u32x2*)(w2 + (size_t)n * 1024 + plane * 512 + g * 128 + c) = o; } }
        }
    }
}

template <int MI, int NI, int KS, bool REAL_IN, bool INV, bool VN>
DEV void cstep(const unsigned char* inR, const unsigned char* inI, int in_rows, int row0, const unsigned char* tabC, const unsigned char* tabS, int tmul, int col0,
               f32x4 (&aR)[MI][NI], f32x4 (&aI)[MI][NI], int lane) {
    lane = opq(lane);
    const int r = lane & 15, q = lane >> 4;
#pragma unroll
    for (int mi = 0; mi < MI; ++mi)
#pragma unroll
        for (int ni = 0; ni < NI; ++ni) { aR[mi][ni] = (f32x4){0.f, 0.f, 0.f, 0.f}; aI[mi][ni] = (f32x4){0.f, 0.f, 0.f, 0.f}; }
    const int toff = (q * 128 + col0 * tmul + ((r * tmul) ^ q)) << 4;
    const int doff = (q * in_rows + row0 + (r ^ q)) << 4;
#pragma unroll 1
    for (int s = 0; s < KS; ++s) {
        bf16x8 fc[NI], fs[NI], fn[NI];
#pragma unroll
        for (int ni = 0; ni < NI; ++ni) { const int o = toff + ((4 * s * 128 + 16 * ni * tmul) << 4);
            fc[ni] = *(const bf16x8*)(tabC + o); fs[ni] = *(const bf16x8*)(tabS + o); fn[ni] = neg8(fs[ni]); }
#pragma unroll
        for (int mi = 0; mi < MI; ++mi) {
            const int o = doff + ((4 * s * in_rows + 16 * mi) << 4);
            const bf16x8 ar = *(const bf16x8*)(inR + o);
            bf16x8 ai = ar;
            if (!REAL_IN) ai = *(const bf16x8*)(inI + o);
#pragma unroll
            for (int ni = 0; ni < NI; ++ni) {
                const bf16x8 sR = INV ? fn[ni] : fs[ni], sI = INV ? fs[ni] : fn[ni];
                if (VN) {
                    aR[mi][ni] = mfma16(fc[ni], ar, aR[mi][ni]); aI[mi][ni] = mfma16(sI, ar, aI[mi][ni]);
                    if (!REAL_IN) { aR[mi][ni] = mfma16(sR, ai, aR[mi][ni]); aI[mi][ni] = mfma16(fc[ni], ai, aI[mi][ni]); }
                } else {
                    aR[mi][ni] = mfma16(ar, fc[ni], aR[mi][ni]); aI[mi][ni] = mfma16(ar, sI, aI[mi][ni]);
                    if (!REAL_IN) { aR[mi][ni] = mfma16(ai, sR, aR[mi][ni]); aI[mi][ni] = mfma16(ai, fc[ni], aI[mi][ni]); }
                }
            }
        }
    }
}
DEV void st4(unsigned char* img, int row, int k, int rows, float a, float b, float c, float d) {
    u32x2 o; o.x = pk2(a, b); o.y = pk2(c, d); *(u32x2*)(img + img_off(row, k >> 3, rows) + (k & 7) * 2) = o;
}
DEV u32x4 pack8(const float* v) { u32x4 o; o.x = pk2(v[0], v[1]); o.y = pk2(v[2], v[3]); o.z = pk2(v[4], v[5]); o.w = pk2(v[6], v[7]); return o; }

#define TASK_PF_HYENA(PF, WS, C, TID) { const bf16_t* ra_ = (const bf16_t*)((WS) + OFF_HF) + (size_t)(C) * L_; const bf16_t* rb_ = (const bf16_t*)((WS) + OFF_HF) + (size_t)(512 + (C)) * L_; \
    _Pragma("unroll") for (int i = 0; i < 4; ++i) { const int ch_ = (TID) + i * NT; PF[i] = *(const u32x4*)(ch_ < 1024 ? ra_ + ch_ * 8 : rb_ + (ch_ - 1024) * 8); } }
#define TASK_PF_FNET(PF, WS, CH, TID) { const bf16_t* s_ = (const bf16_t*)((WS) + OFF_PT) + (size_t)(1536 + (CH)) * T_; \
    _Pragma("unroll") for (int it = 0; it < 2; ++it) { const int u_ = (TID) + it * NT; const int mp_ = u_ & 63, b_ = (u_ >> 6) & 1, kc_ = u_ >> 7; \
        _Pragma("unroll") for (int j = 0; j < 8; ++j) PF[it * 2 + (j >> 2)][j & 3] = *(const unsigned*)(s_ + b_ * L_ + 128 * (8 * kc_ + j) + 2 * mp_); } }
DEV void hyena_task(CParams& p, int c, int tk, unsigned char* smem, u32x4 (&pf)[4], int next_c, int next_fnet) {
    const int tid = opq((int)threadIdx.x), lane = tid & 63, w = tid >> 6; int r, q;
    unsigned char* ws = opqp(PWS);
    const unsigned char* tabC = smem; const unsigned char* tabS = smem + 32768;
    unsigned char* dR = smem + 65536; unsigned char* dI = smem + 98304;
    float* red = (float*)(smem + 131072);
    const int row0 = 64 * (w >> 2), col0 = 32 * (w & 3), col0h = 16 * (w & 3);
    unsigned* kf = (unsigned*)(ws + OFF_HN) + (size_t)BID() * 32768;
    const bf16_t* hfT = (const bf16_t*)(ws + OFF_HF);
    const bf16_t* pT = (const bf16_t*)(ws + OFF_PT);
    bf16_t* zT = (bf16_t*)(ws + OFF_ZHY) + (size_t)c * T_;
    const float* cw = PIN(4); const float* cbv = PIN(5); const float* skip = PIN(11);
    const float inv16384 = 1.0f / 16384.0f;

    const bf16_t* pv = pT + (size_t)c * T_; const bf16_t* px1 = pT + (size_t)(512 + c) * T_; const bf16_t* px2 = pT + (size_t)(1024 + c) * T_;
#define PF_LOAD(ROWA, ROWB) { _Pragma("unroll") for (int i = 0; i < 4; ++i) { const int ch = tid + i * NT; pf[i] = *(const u32x4*)(ch < 1024 ? (ROWA) + ch * 8 : (ROWB) + (ch - 1024) * 8); } }
    {
        unsigned char* xraw = smem + 135168;
        float part0 = 0.f, part1 = 0.f;
#define KF_BUILD(DST, RAWF, RAWB, HALF, PART) { const int u = tid + (HALF) * NT; const int mp = u & 63, kc = u >> 6; unsigned e0[8], e1[8]; \
            _Pragma("unroll") for (int j = 0; j < 8; ++j) { const int n1 = 8 * kc + j, n = 128 * n1 + 2 * mp; \
                if ((HALF) == 0) { const unsigned d = *(const unsigned*)((RAWF) + n); e0[j] = d & 0xffffu; e1[j] = d >> 16; } \
                else { const unsigned v0 = (unsigned)(RAWB)[min(16384 - n, 8191)]; e0[j] = (n == 8192) ? 0u : v0; e1[j] = (unsigned)(RAWB)[16383 - n]; } \
                PART += fabsf(__uint_as_float(e0[j] << 16)) + fabsf(__uint_as_float(e1[j] << 16)); } \
            u32x4 lo, hi; \
            lo.x = e0[0] | (e0[1] << 16); lo.y = e0[2] | (e0[3] << 16); lo.z = e0[4] | (e0[5] << 16); lo.w = e0[6] | (e0[7] << 16); \
            hi.x = e1[0] | (e1[1] << 16); hi.y = e1[2] | (e1[3] << 16); hi.z = e1[4] | (e1[5] << 16); hi.w = e1[6] | (e1[7] << 16); \
            *(u32x4*)((DST) + img_off(2 * mp, kc, 128)) = lo; *(u32x4*)((DST) + img_off(2 * mp + 1, kc, 128)) = hi; }
        lds_barrier();
#pragma unroll
        for (int i = 0; i < 4; ++i) { const int ch = tid + i * NT; *(u32x4*)(dI + ch * 16) = pf[i]; }
        PF_LOAD(hfT + (size_t)(2 * 512 + c) * L_, hfT + (size_t)(3 * 512 + c) * L_);
        lds_barrier();
        { const bf16_t* raw = (const bf16_t*)dI; KF_BUILD(dR, raw, raw + 8192, 0, part0); KF_BUILD(dR, raw, raw + 8192, 1, part0); }
        lds_barrier();
#pragma unroll
        for (int i = 0; i < 4; ++i) { const int ch = tid + i * NT; *(u32x4*)((ch < 1024 ? dI + 16384 : xraw - 16384) + ch * 16) = pf[i]; }
        PF_LOAD(pv, pv + L_);
        lds_barrier();
        { const bf16_t* rawf = (const bf16_t*)(dI + 16384); const bf16_t* rawb = (const bf16_t*)xraw; KF_BUILD(dI, rawf, rawb, 0, part1); lds_barrier(); KF_BUILD(dI, rawf, rawb, 1, part1); }
#undef KF_BUILD
        part0 = wave_sum(part0); part1 = wave_sum(part1);
        if (lane == 0) { red[w] = part0; red[8 + w] = part1; }
        lds_barrier();
        float S0 = 0.f, S1 = 0.f;
#pragma unroll
        for (int i = 0; i < 8; ++i) { S0 += red[i]; S1 += red[8 + i]; }
        const float h0 = 0.5f * inv16384 / S0, h1 = 0.5f * inv16384 / S1;
        f32x4 aR[4][2], aI[4][2];
        cstep<4, 2, 4, false, false, false>(dR, dI, 128, row0, tabC, tabS, 1, col0, aR, aI, lane);
        lds_barrier();
        RQ
#pragma unroll
        for (int mi = 0; mi < 4; ++mi)
#pragma unroll
            for (int ni = 0; ni < 2; ++ni) { const int k1 = col0 + 16 * ni + r, n2 = row0 + 16 * mi + 4 * q; float orr[4], oi[4];
                const float a0 = (float)(n2 * k1) * inv16384, a1 = (float)k1 * inv16384;
                float cs = __builtin_amdgcn_cosf(a0), sn = __builtin_amdgcn_sinf(a0); const float cd = __builtin_amdgcn_cosf(a1), sd = __builtin_amdgcn_sinf(a1);
#pragma unroll
                for (int i = 0; i < 4; ++i) {
                    const float xr = aR[mi][ni][i], xi = aI[mi][ni][i]; orr[i] = xr * cs + xi * sn; oi[i] = xi * cs - xr * sn;
                    const float cn = cs * cd - sn * sd, sm = sn * cd + cs * sd; cs = cn; sn = sm; }
                st4(dR, k1, n2, 128, orr[0], orr[1], orr[2], orr[3]); st4(dI, k1, n2, 128, oi[0], oi[1], oi[2], oi[3]); __builtin_amdgcn_sched_barrier(0); }
        lds_barrier();
        cstep<4, 2, 4, false, false, true>(dR, dI, 128, row0, tabC, tabS, 1, col0, aR, aI, lane);
        lds_barrier();
        RQ
#pragma unroll
        for (int mi = 0; mi < 4; ++mi)
#pragma unroll
            for (int ni = 0; ni < 2; ++ni) { const int k1 = row0 + 16 * mi + r, k2 = col0 + 16 * ni + 4 * q; u32x2 vr, vi;
                vr.x = pk2(aR[mi][ni][0], aR[mi][ni][1]); vr.y = pk2(aR[mi][ni][2], aR[mi][ni][3]); vi.x = pk2(aI[mi][ni][0], aI[mi][ni][1]); vi.y = pk2(aI[mi][ni][2], aI[mi][ni][3]);
                *(u32x2*)(dR + (k1 * 128 + k2) * 2) = vr; *(u32x2*)(dI + (k1 * 128 + k2) * 2) = vi; }
        lds_barrier();
#pragma unroll 2
        for (int it = 0; it < 8; ++it) { const int qd = tid + it * NT, k1 = qd >> 5, k2 = (qd & 31) << 2, k1m = (128 - k1) & 127;
            const u32x2 ar_ = *(const u32x2*)(dR + (k1 * 128 + k2) * 2), ai_ = *(const u32x2*)(dI + (k1 * 128 + k2) * 2);
            const u32x2 mr_ = *(const u32x2*)(dR + (k1m * 128 + 124 - k2) * 2), mi_ = *(const u32x2*)(dI + (k1m * 128 + 124 - k2) * 2);
            const int ks = (128 - k2) & 127;
            const float sr = bf2f(((const bf16_t*)dR)[ks]), si = bf2f(((const bf16_t*)dI)[ks]);
            const float a_r[4] = {bf_lo(ar_.x), bf_hi(ar_.x), bf_lo(ar_.y), bf_hi(ar_.y)}, a_i[4] = {bf_lo(ai_.x), bf_hi(ai_.x), bf_lo(ai_.y), bf_hi(ai_.y)};
            const float e_r[4] = {bf_lo(mr_.x), bf_hi(mr_.x), bf_lo(mr_.y), bf_hi(mr_.y)}, e_i[4] = {bf_lo(mi_.x), bf_hi(mi_.x), bf_lo(mi_.y), bf_hi(mi_.y)};
            u32x4 o0, o1;
#pragma unroll
            for (int j = 0; j < 4; ++j) { const float mr = k1 ? e_r[3 - j] : (j == 0 ? sr : e_r[(4 - j) & 3]), mi2 = k1 ? e_i[3 - j] : (j == 0 ? si : e_i[(4 - j) & 3]);
                o0[j] = pk2((a_r[j] + mr) * h0, (a_i[j] - mi2) * h0); o1[j] = pk2((a_i[j] + mi2) * h1, (mr - a_r[j]) * h1); }
            *(u32x4*)(kf + k1 * 128 + k2) = o0; *(u32x4*)(kf + 16384 + k1 * 128 + k2) = o1; }
    }
    const float wv0 = cw[c], wv1 = cw[1536 + c], wv2 = cw[3072 + c], cv = cbv[c];
    const float wa0 = cw[512 + c], wa1 = cw[1536 + 512 + c], wa2 = cw[3072 + 512 + c], ca = cbv[512 + c];
    const float wb0 = cw[1024 + c], wb1 = cw[1536 + 1024 + c], wb2 = cw[3072 + 1024 + c], cb = cbv[1024 + c];
    const float sk0 = skip[c], sk1 = skip[512 + c];
    lds_barrier();
    bf16_t* usc = (bf16_t*)(ws + OFF_USC) + (size_t)BID() * (3 * 2 * 128 * 64);
    {
        const int mp = tid & 63, kc = tid >> 6;
#pragma unroll
        for (int sig = 0; sig < 3; ++sig) {
            const float w0 = sig == 0 ? wv0 : sig == 1 ? wa0 : wb0, w1 = sig == 0 ? wv1 : sig == 1 ? wa1 : wb1, w2 = sig == 0 ? wv2 : sig == 1 ? wa2 : wb2, cc = sig == 0 ? cv : sig == 1 ? ca : cb;
            const bf16_t* ps = sig == 0 ? pv : sig == 1 ? px1 : px2;
            if (sig) lds_barrier();
#pragma unroll
            for (int i = 0; i < 4; ++i) { const int ch = tid + i * NT, b = ch >> 10, cidx = ch & 1023;
                *(u32x4*)((b ? dI : dR) + 16384 + cidx * 16) = pf[i]; }
            if (sig < 2) { const bf16_t* nx = sig == 0 ? px1 : px2; PF_LOAD(nx, nx + L_); }
            lds_barrier();
#pragma unroll
            for (int b = 0; b < 2; ++b) {
                const bf16_t* pr = (const bf16_t*)((b ? dI : dR) + 16384);
                float u0[8], u1[8];
#pragma unroll
                for (int j = 0; j < 8; ++j) { const int l = 128 * (8 * kc + j) + 2 * mp;
                    const float pmv = bf2f(pr[max(l - 1, 0)]); const unsigned d = *(const unsigned*)(pr + l); const float p0 = bf_lo(d), p1 = bf_hi(d);
                    const float ppv = bf2f(pr[min(l + 2, L_ - 1)]);
                    const float pm = l > 0 ? pmv : 0.f, pp = (l + 2 < L_) ? ppv : 0.f;
                    u0[j] = w0 * pm + w1 * p0 + w2 * p1 + cc; u1[j] = w0 * p0 + w1 * p1 + w2 * pp + cc; }
                const u32x4 lo = pack8(u0), hi = pack8(u1);
                if (sig == 0) { unsigned char* dst = b ? dI : dR; *(u32x4*)(dst + img_off(2 * mp, kc, 128)) = lo; *(u32x4*)(dst + img_off(2 * mp + 1, kc, 128)) = hi; }
                bf16_t* ud = usc + ((size_t)(sig * 2 + b) * 128 + 2 * mp) * 64 + 8 * kc;
                *(u32x4*)ud = lo; *(u32x4*)(ud + 64) = hi;
            }
        }
    }
    lds_barrier();
    float z1r[4][4], z1i[4][4];
#pragma unroll
    for (int o = 0; o < 2; ++o) {
        f32x4 aR[4][2], aI[4][2];
        const int nblk_ = NBLK(), bid_ = BID(); const bool bgj = nblk_ == 256;
        const float* cv_src = o == 0 ? PIN(18) : PIN(19); unsigned* cv_dst = (unsigned*)(ws + (o == 0 ? OFF_U : OFF_V)); float* cv_sc = (float*)(ws + (o == 0 ? OFF_US : OFF_VS)); const float* cv_gain = o == 0 ? PIN(15) : nullptr;
        f32x4 cv[2][4];
#define CV_ISSUE(PT) if (bgj) { const int row0_ = 2 * ((((tk * 2 + (PT)) * 256 + bid_) * 8) + (tid >> 6)); _Pragma("unroll") for (int k = 0; k < 2; ++k) _Pragma("unroll") for (int i = 0; i < 4; ++i) cv[k][i] = *(const f32x4*)(cv_src + (size_t)(row0_ + k) * 1024 + 4 * lane + 256 * i); }
#define CV_FINISH(PT) if (bgj) { const int row0_ = 2 * ((((tk * 2 + (PT)) * 256 + bid_) * 8) + (tid >> 6)); cv_finish(cv, cv_dst, cv_sc, cv_gain, row0_, lane, true); }
        CV_ISSUE(0)
        cstep<4, 2, 2, false, false, false>(dR, dI, 128, row0, tabC, tabS, 1, col0, aR, aI, lane);
        lds_barrier();
        RQ
#pragma unroll
        for (int mi = 0; mi < 4; ++mi)
#pragma unroll
            for (int ni = 0; ni < 2; ++ni) { const int k1 = col0 + 16 * ni + r, n2 = row0 + 16 * mi + 4 * q; float orr[4], oi[4];
                const float a0 = (float)(n2 * k1) * inv16384, a1 = (float)k1 * inv16384;
                float cs = __builtin_amdgcn_cosf(a0), sn = __builtin_amdgcn_sinf(a0); const float cd = __builtin_amdgcn_cosf(a1), sd = __builtin_amdgcn_sinf(a1);
#pragma unroll
                for (int i = 0; i < 4; ++i) {
                    const float xr = aR[mi][ni][i], xi = aI[mi][ni][i]; orr[i] = xr * cs + xi * sn; oi[i] = xi * cs - xr * sn;
                    const float cn = cs * cd - sn * sd, sm = sn * cd + cs * sd; cs = cn; sn = sm; }
                st4(dR, k1, n2, 128, orr[0], orr[1], orr[2], orr[3]); st4(dI, k1, n2, 128, oi[0], oi[1], oi[2], oi[3]); __builtin_amdgcn_sched_barrier(0); }
        CV_FINISH(0)
        lds_barrier();
        u32x4 kfr[4][2];
        RQ
#pragma unroll
        for (int mi = 0; mi < 4; ++mi)
#pragma unroll
            for (int ni = 0; ni < 2; ++ni) kfr[mi][ni] = *(const u32x4*)(kf + o * 16384 + (row0 + 16 * mi + r) * 128 + col0 + 16 * ni + 4 * q);
        cstep<4, 2, 4, false, false, true>(dR, dI, 128, row0, tabC, tabS, 1, col0, aR, aI, lane);
        lds_barrier();
        RQ
#pragma unroll
        for (int mi = 0; mi < 4; ++mi)
#pragma unroll
            for (int ni = 0; ni < 2; ++ni) { const int k1 = row0 + 16 * mi + r, k2 = col0 + 16 * ni + 4 * q; float orr[4], oi[4];
                const u32x4 kk = kfr[mi][ni];
#pragma unroll
                for (int i = 0; i < 4; ++i) { const float kr = bf_lo(kk[i]), ki = bf_hi(kk[i]); const float xr = aR[mi][ni][i], xi = aI[mi][ni][i];
                    orr[i] = xr * kr - xi * ki; oi[i] = xr * ki + xi * kr; }
                st4(dR, k1, k2, 128, orr[0], orr[1], orr[2], orr[3]); st4(dI, k1, k2, 128, oi[0], oi[1], oi[2], oi[3]); __builtin_amdgcn_sched_barrier(0); }
        lds_barrier();
        CV_ISSUE(1)
        cstep<4, 2, 4, false, true, false>(dR, dI, 128, row0, tabC, tabS, 1, col0, aR, aI, lane);
        lds_barrier();
        RQ
#pragma unroll
        for (int mi = 0; mi < 4; ++mi)
#pragma unroll
            for (int ni = 0; ni < 2; ++ni) { const int n2 = col0 + 16 * ni + r, k1 = row0 + 16 * mi + 4 * q; float orr[4], oi[4];
                const float a0 = (float)(n2 * k1) * inv16384, a1 = (float)n2 * inv16384;
                float cs = __builtin_amdgcn_cosf(a0), sn = __builtin_amdgcn_sinf(a0); const float cd = __builtin_amdgcn_cosf(a1), sd = __builtin_amdgcn_sinf(a1);
#pragma unroll
                for (int i = 0; i < 4; ++i) {
                    const float xr = aR[mi][ni][i], xi = aI[mi][ni][i]; orr[i] = xr * cs - xi * sn; oi[i] = xr * sn + xi * cs;
                    const float cn = cs * cd - sn * sd, sm = sn * cd + cs * sd; cs = cn; sn = sm; }
                st4(dR, n2, k1, 128, orr[0], orr[1], orr[2], orr[3]); st4(dI, n2, k1, 128, oi[0], oi[1], oi[2], oi[3]); __builtin_amdgcn_sched_barrier(0); }
        CV_FINISH(1)
        __syncthreads();
        u32x2 pre[4][4];
        RQ
#pragma unroll
        for (int mi = 0; mi < 4; ++mi) { const bf16_t* ub = usc + (size_t)(row0 + 16 * mi + r) * 64 + col0h + 4 * q;
            if (o == 0) { pre[mi][0] = *(const u32x2*)(ub); pre[mi][1] = *(const u32x2*)(ub + 8192); pre[mi][2] = *(const u32x2*)(ub + 2 * 8192); pre[mi][3] = *(const u32x2*)(ub + 3 * 8192); }
            else { pre[mi][0] = *(const u32x2*)(ub + 4 * 8192); pre[mi][1] = *(const u32x2*)(ub + 5 * 8192); } }
        f32x4 yR[4][1], yI[4][1];
        cstep<4, 1, 4, false, true, true>(dR, dI, 128, row0, tabC, tabS, 1, col0h, yR, yI, lane);
        lds_barrier();
        RQ
#pragma unroll
        for (int mi = 0; mi < 4; ++mi) { const int n2 = row0 + 16 * mi + r, n1 = col0h + 4 * q;
            if (o == 0) {
                const u32x2 v0 = pre[mi][0], v1 = pre[mi][1], a0 = pre[mi][2], a1 = pre[mi][3];
                const float vv0[4] = {bf_lo(v0.x), bf_hi(v0.x), bf_lo(v0.y), bf_hi(v0.y)}, vv1[4] = {bf_lo(v1.x), bf_hi(v1.x), bf_lo(v1.y), bf_hi(v1.y)};
                const float aa0[4] = {bf_lo(a0.x), bf_hi(a0.x), bf_lo(a0.y), bf_hi(a0.y)}, aa1[4] = {bf_lo(a1.x), bf_hi(a1.x), bf_lo(a1.y), bf_hi(a1.y)};
#pragma unroll
                for (int i = 0; i < 4; ++i) { z1r[mi][i] = aa0[i] * (yR[mi][0][i] + sk0 * vv0[i]); z1i[mi][i] = aa1[i] * (yI[mi][0][i] + sk0 * vv1[i]); }
                st4(dR, n2, n1, 128, z1r[mi][0], z1r[mi][1], z1r[mi][2], z1r[mi][3]); st4(dI, n2, n1, 128, z1i[mi][0], z1i[mi][1], z1i[mi][2], z1i[mi][3]);
            } else {
                const u32x2 b0 = pre[mi][0], b1 = pre[mi][1];
                const float bb0[4] = {bf_lo(b0.x), bf_hi(b0.x), bf_lo(b0.y), bf_hi(b0.y)}, bb1[4] = {bf_lo(b1.x), bf_hi(b1.x), bf_lo(b1.y), bf_hi(b1.y)};
#pragma unroll
                for (int i = 0; i < 4; ++i) { const int l = 128 * (n1 + i) + n2;
                    const float zr = bb0[i] * (yR[mi][0][i] + sk1 * z1r[mi][i]);
                    const float zi = bb1[i] * (yI[mi][0][i] + sk1 * z1i[mi][i]);
                    ((bf16_t*)dR)[l] = (bf16_t)(pk2(zr, 0.f) & 0xffffu); ((bf16_t*)dI)[l] = (bf16_t)(pk2(zi, 0.f) & 0xffffu); }
            }
        }
        lds_barrier();
        if (o == 1) {
            if (next_c >= 0) TASK_PF_HYENA(pf, ws, next_c, tid) else TASK_PF_FNET(pf, ws, next_fnet, tid)
#pragma unroll
            for (int i = 0; i < 4; ++i) { const int ch = tid + i * NT, b = ch >> 10, cidx = ch & 1023;
                *(u32x4*)(zT + b * L_ + cidx * 8) = *(const u32x4*)((b ? dI : dR) + cidx * 16); }
        }
    }
}

DEV void fnet_task(CParams& p, int ch, unsigned char* smem, u32x4 (&pf)[4], int next_ch) {
    const int tid = opq((int)threadIdx.x), lane = tid & 63, w = tid >> 6; int r, q;
    unsigned char* ws = opqp(PWS);
    const unsigned char* tabC = smem; const unsigned char* tabS = smem + 32768;
    unsigned char* d0 = smem + 65536; unsigned char* d1 = smem + 98304;
    const bf16_t* src = (const bf16_t*)(ws + OFF_PT) + (size_t)(1536 + ch) * T_;
    bf16_t* PT = (bf16_t*)(ws + OFF_PRI);
    lds_barrier();
#pragma unroll
    for (int it = 0; it < 2; ++it) { const int u = tid + it * NT;
        const int mp = u & 63, b = (u >> 6) & 1, kc = u >> 7;
        unsigned d[8];
#pragma unroll
        for (int j = 0; j < 8; ++j) d[j] = pf[it * 2 + (j >> 2)][j & 3];
        u32x4 lo, hi;
        lo.x = (d[0] & 0xffffu) | (d[1] << 16); lo.y = (d[2] & 0xffffu) | (d[3] << 16); lo.z = (d[4] & 0xffffu) | (d[5] << 16); lo.w = (d[6] & 0xffffu) | (d[7] << 16);
        hi.x = (d[0] >> 16) | (d[1] & 0xffff0000u); hi.y = (d[2] >> 16) | (d[3] & 0xffff0000u); hi.z = (d[4] >> 16) | (d[5] & 0xffff0000u); hi.w = (d[6] >> 16) | (d[7] & 0xffff0000u);
        *(u32x4*)(d0 + img_off(b * 128 + 2 * mp, kc, 256)) = lo; *(u32x4*)(d0 + img_off(b * 128 + 2 * mp + 1, kc, 256)) = hi;
    }
    if (next_ch >= 0) TASK_PF_FNET(pf, ws, next_ch, tid) else { _Pragma("unroll") for (int i = 0; i < 4; ++i) pf[i] = (u32x4){0u, 0u, 0u, 0u}; }
    lds_barrier();
    f32x4 aR[4][2], aI[4][2];
    {
        const int row0 = 64 * (w >> 1), col0 = 32 * (w & 1);
        cstep<4, 2, 2, true, false, false>(d0, d0, 256, row0, tabC, tabS, 2, col0, aR, aI, lane);
        lds_barrier();
        RQ
#pragma unroll
        for (int mi = 0; mi < 4; ++mi)
#pragma unroll
            for (int ni = 0; ni < 2; ++ni) { const int k1 = col0 + 16 * ni + r, rows = row0 + 16 * mi + 4 * q, n2 = rows & 127; float orr[4], oi[4];
#pragma unroll
                for (int i = 0; i < 4; ++i) { const float ang = (float)((n2 + i) * k1) * (1.0f / 8192.0f); const float cs = __builtin_amdgcn_cosf(ang), sn = __builtin_amdgcn_sinf(ang);
                    const float xr = aR[mi][ni][i], xi = aI[mi][ni][i]; orr[i] = xr * cs + xi * sn; oi[i] = xi * cs - xr * sn; }
                st4(d0, k1, rows, 64, orr[0], orr[1], orr[2], orr[3]); st4(d1, k1, rows, 64, oi[0], oi[1], oi[2], oi[3]); __builtin_amdgcn_sched_barrier(0); }
        lds_barrier();
    }
    {
        const int b = w >> 2, col0 = 32 * (w & 3);
        cstep<4, 2, 4, false, false, false>(d0 + b * 16384, d1 + b * 16384, 64, 0, tabC, tabS, 1, col0, aR, aI, lane);
        RQ
#pragma unroll
        for (int mi = 0; mi < 4; ++mi)
#pragma unroll
            for (int ni = 0; ni < 2; ++ni) { const int k2 = col0 + 16 * ni + r, k1 = 16 * mi + 4 * q; const size_t o = (size_t)ch * T_ + b * L_ + 64 * k2 + k1;
                u32x2 vr, vi; vr.x = pk2(aR[mi][ni][0], aR[mi][ni][1]); vr.y = pk2(aR[mi][ni][2], aR[mi][ni][3]); vi.x = pk2(aI[mi][ni][0], aI[mi][ni][1]); vi.y = pk2(aI[mi][ni][2], aI[mi][ni][3]);
                *(u32x2*)(PT + o) = vr; *(u32x2*)(PT + (size_t)512 * T_ + o) = vi; }
        float mr_ = 0.f, mi_ = 0.f;
#pragma unroll
        for (int mi = 0; mi < 4; ++mi)
#pragma unroll
            for (int ni = 0; ni < 2; ++ni)
#pragma unroll
                for (int i = 0; i < 4; ++i) { mr_ = fmaxf(mr_, fabsf(aR[mi][ni][i])); mi_ = fmaxf(mi_, fabsf(aI[mi][ni][i])); }
#pragma unroll
        for (int o = 32; o; o >>= 1) { mr_ = fmaxf(mr_, __shfl_xor(mr_, o)); mi_ = fmaxf(mi_, __shfl_xor(mi_, o)); }
        float* red_ = (float*)(smem + 131072);
        if (lane == 0) { red_[w] = mr_; red_[8 + w] = mi_; }
        lds_barrier();
        if (tid < 2) { float m_ = 0.f;
#pragma unroll
            for (int i = 0; i < 8; ++i) m_ = fmaxf(m_, red_[8 * tid + i]);
            ((float*)(ws + OFF_CHM))[512 * tid + ch] = m_; }
    }
}

DEV void fold_tile(CParams& p) {
    const int tid = opq((int)threadIdx.x), lane = tid & 63, w = tid >> 6, r = lane & 15, q = lane >> 4, bid = BID();
    unsigned char* ws = opqp(PWS);
    const bf16_t* dt = (const bf16_t*)(ws + OFF_DT); const bf16_t* wfn = (const bf16_t*)(ws + OFF_WFN); bf16_t* w2 = (bf16_t*)(ws + OFF_W2);
    const int n0 = (bid >> 4) * 64, cbk = bid & 15, plane = cbk >> 3, g = (cbk >> 1) & 3, c0 = (cbk & 1) * 64;
    const int mt = w & 3, nt0 = 2 * (w >> 2);
    bf16x8 a[4], b[2][4];
#pragma unroll
    for (int s = 0; s < 4; ++s) { a[s] = *(const bf16x8*)(dt + (size_t)(plane * 128 + c0 + 16 * mt + r) * 128 + 32 * s + 8 * q);
#pragma unroll
        for (int t = 0; t < 2; ++t) b[t][s] = *(const bf16x8*)(wfn + (size_t)(n0 + 16 * (nt0 + t) + r) * 512 + g * 128 + 32 * s + 8 * q); }
#pragma unroll
    for (int t = 0; t < 2; ++t) { f32x4 acc = {0.f, 0.f, 0.f, 0.f};
#pragma unroll
        for (int s = 0; s < 4; ++s) acc = mfma16(a[s], b[t][s], acc);
        u32x2 o; o.x = pk2(acc[0], acc[1]); o.y = pk2(acc[2], acc[3]);
        *(u32x2*)(w2 + (size_t)(n0 + 16 * (nt0 + t) + r) * 1024 + plane * 512 + g * 128 + c0 + 16 * mt + 4 * q) = o; }
}
DEV void phase2(CParams& p, unsigned char* smem) {
    u32x4 pf[4];
    { const int t_ = opq((int)threadIdx.x); unsigned char* ws_ = opqp(PWS); TASK_PF_HYENA(pf, ws_, BID(), t_) }
    if (NBLK() == 256) fold_tile(p);
    __syncthreads();
    for (int i = opq((int)threadIdx.x); i < 4096; i += NT) ((u32x4*)smem)[i] = ((const u32x4*)(PWS + OFF_TAB))[i];
    __syncthreads();
    { const int nb_ = NBLK(), bid_ = BID(); int tk = 0;
      for (int c = bid_; c < 512; c += nb_, ++tk) hyena_task(p, c, tk, smem, pf, c + nb_ < 512 ? c + nb_ : -1, bid_);
      for (int ch = bid_; ch < 512; ch += nb_) fnet_task(p, ch, smem, pf, ch + nb_ < 512 ? ch + nb_ : -1); }
}

DEV void tr16_wave(const bf16_t* __restrict__ src, int R, int C, int r0, int c0, bf16_t* __restrict__ dst, int lane) {
    const int rb = lane >> 3, cb = lane & 7;
    u32x4 in[8];
#pragma unroll
    for (int i = 0; i < 8; ++i) in[i] = *(const u32x4*)(src + (size_t)(r0 + 8 * rb + i) * C + c0 + 8 * cb);
#pragma unroll
    for (int j = 0; j < 8; ++j) { u32x4 o;
#pragma unroll
        for (int pp = 0; pp < 4; ++pp) { const unsigned a = in[2 * pp][j >> 1], b = in[2 * pp + 1][j >> 1];
            o[pp] = (j & 1) ? ((a >> 16) | (b & 0xffff0000u)) : ((a & 0xffffu) | (b << 16)); }
        *(u32x4*)(dst + (size_t)(c0 + 8 * cb + j) * R + r0 + 8 * rb) = o; }
}
DEV void tr8_tile(const u32x4 (&in)[8], const float* __restrict__ chm, unsigned char* __restrict__ dst8, int R8, int r0, int c0, int lane) {
    const int rb = lane >> 3, cbl = lane & 7;
    float sc[8];
#pragma unroll
    for (int i = 0; i < 8; ++i) { const float m = chm[r0 + 8 * rb + i]; sc[i] = m > 0.f ? 127.0f / m : 0.f; }
#pragma unroll
    for (int j = 0; j < 8; ++j) { float v[8];
#pragma unroll
        for (int i = 0; i < 8; ++i) { const unsigned d = in[i][j >> 1]; v[i] = ((j & 1) ? bf_hi(d) : bf_lo(d)) * sc[i]; }
        u32x2 o; o.x = pack_i8x4(v[0], v[1], v[2], v[3], 1.0f); o.y = pack_i8x4(v[4], v[5], v[6], v[7], 1.0f);
        *(u32x2*)(dst8 + (size_t)(c0 + 8 * cbl + j) * R8 + r0 + 8 * rb) = o; }
}
DEV void phase3(CParams& p, unsigned char* smem) {
    const bool not256 = NBLK() != 256;
    const int tid = opq((int)threadIdx.x); const int lane = tid & 63, wave = tid >> 6;
    unsigned char* ws = opqp(PWS);
    const int bid = BID(), istep = NBLK() * 8;
    if (!not256) {
        const int g = bid & 7, wg = (bid >> 3) * 8 + wave;
        u32x4 in[3][8]; const int rb = lane >> 3, cbl = lane & 7;
#pragma unroll
        for (int k = 0; k < 3; ++k) { const int idx = wg + 256 * k, tb = 32 * g + (idx & 31), cb = idx >> 5;
            const bf16_t* s_ = k == 0 ? (const bf16_t*)(ws + OFF_ZHY) : (const bf16_t*)(ws + OFF_PRI); const int r0 = (k == 0 ? cb : cb - 8) * 64, c0 = tb * 64;
#pragma unroll
            for (int i = 0; i < 8; ++i) in[k][i] = *(const u32x4*)(s_ + (size_t)(r0 + 8 * rb + i) * T_ + c0 + 8 * cbl); }
#pragma unroll
        for (int k = 0; k < 3; ++k) { const int idx = wg + 256 * k, tb = 32 * g + (idx & 31), cb = idx >> 5;
            bf16_t* d_ = k == 0 ? (bf16_t*)(ws + OFF_ZR) : (bf16_t*)(ws + OFF_PR); const int R = k == 0 ? 512 : 1024, r0 = (k == 0 ? cb : cb - 8) * 64, c0 = tb * 64;
            if (k > 0) { tr8_tile(in[k], (const float*)(ws + OFF_CHM), ws + OFF_PR, 1024, r0, c0, lane); continue; }
#pragma unroll
            for (int j = 0; j < 8; ++j) { u32x4 o;
#pragma unroll
                for (int pp = 0; pp < 4; ++pp) { const unsigned a = in[k][2 * pp][j >> 1], b = in[k][2 * pp + 1][j >> 1];
                    o[pp] = (j & 1) ? ((a >> 16) | (b & 0xffff0000u)) : ((a & 0xffffu) | (b << 16)); }
                *(u32x4*)(d_ + (size_t)(c0 + 8 * cbl + j) * R + r0 + 8 * rb) = o; } }
    } else
    for (int i = bid * 8 + wave; i < 6144; i += istep) {
        if (i < 2048) tr16_wave((const bf16_t*)(ws + OFF_ZHY), 512, T_, (i >> 8) * 64, (i & 255) * 64, (bf16_t*)(ws + OFF_ZR), lane);
        else { const int j = i - 2048, r0 = (j >> 8) * 64, c0 = (j & 255) * 64, rb = lane >> 3, cbl = lane & 7; u32x4 in8[8];
#pragma unroll
            for (int ii = 0; ii < 8; ++ii) in8[ii] = *(const u32x4*)((const bf16_t*)(ws + OFF_PRI) + (size_t)(r0 + 8 * rb + ii) * T_ + c0 + 8 * cbl);
            tr8_tile(in8, (const float*)(ws + OFF_CHM), ws + OFF_PR, 1024, r0, c0, lane); }
    }
    {
        const bf16_t* w2 = (const bf16_t*)(ws + OFF_W2); const float* chm = (const float*)(ws + OFF_CHM); unsigned* w28 = (unsigned*)(ws + OFF_W28); float* w2s = (float*)(ws + OFF_W2S);
        for (int n = bid * 8 + wave; n < 1024; n += istep) {
            const u32x4 r0_ = *(const u32x4*)(w2 + (size_t)n * 1024 + 16 * lane), r1_ = *(const u32x4*)(w2 + (size_t)n * 1024 + 16 * lane + 8);
            f32x4 a[4]; unpack8v(r0_, a[0], a[1]); unpack8v(r1_, a[2], a[3]);
            float am = 0.f;
#pragma unroll
            for (int k = 0; k < 4; ++k) { a[k] = a[k] * *(const f32x4*)(chm + 16 * lane + 4 * k) * (1.0f / 127.0f);
                am = fmaxf(am, fmaxf(fmaxf(fabsf(a[k][0]), fabsf(a[k][1])), fmaxf(fabsf(a[k][2]), fabsf(a[k][3])))); }
#pragma unroll
            for (int o = 32; o; o >>= 1) am = fmaxf(am, __shfl_xor(am, o));
            const float inv = am > 0.f ? 127.0f / am : 0.f;
            u32x4 qv;
#pragma unroll
            for (int k = 0; k < 4; ++k) qv[k] = pack_i8x4(a[k][0], a[k][1], a[k][2], a[k][3], inv);
            *(u32x4*)(w28 + (size_t)n * 256 + 4 * lane) = qv;
            if (lane == 0) w2s[n] = am * (1.0f / 127.0f);
        }
    }
    if (not256) cvt8_rows(PIN(19), (unsigned*)(ws + OFF_V), (float*)(ws + OFF_VS), lane, wave, nullptr, true);
}

DEV void phase4(CParams& p, unsigned char* smem) {
    unsigned char* ws = opqp(PWS);
    const bf16_t* sg = (const bf16_t*)POUT;
    bf16_t* merged = (bf16_t*)(ws + OFF_MERGED);
    const float* w2s = (const float*)(ws + OFF_W2S);
    typedef int i32x4_t __attribute__((ext_vector_type(4)));
    struct L4 { u32x4 a, b; f32x4 s0, s1; };
    auto mpre = [=](int row, int col0) { L4 l; l.a = *(const u32x4*)(sg + (size_t)row * 2048 + 1024 + col0); l.b = *(const u32x4*)(sg + (size_t)row * 2048 + col0);
        l.s0 = *(const f32x4*)(w2s + col0); l.s1 = *(const f32x4*)(w2s + col0 + 4); return l; };
    auto mpost = [=](f32x4& v0, f32x4& v1, const L4& l) { f32x4 g0, g1, h0, h1; unpack8v(l.a, g0, g1); unpack8v(l.b, h0, h1);
        f32x4 y0 = __builtin_convertvector(__builtin_bit_cast(i32x4_t, v0), f32x4) * l.s0 * g0, y1 = __builtin_convertvector(__builtin_bit_cast(i32x4_t, v1), f32x4) * l.s1 * g1;
#pragma unroll
        for (int e = 0; e < 4; ++e) { y0[e] *= __builtin_amdgcn_rcpf(fmaxf(h0[e], 1e-30f)); y1[e] *= __builtin_amdgcn_rcpf(fmaxf(h1[e], 1e-30f)); }
        v0 = y0; v1 = y1; asm volatile("" : "+v"(v0), "+v"(v1)); };
    auto pre = [=](int row, int col0) { L1u l; l.a = *(const u32x4*)(sg + (size_t)row * 2048 + col0); return l; };
    auto post = [=](int row, int col0, f32x4 v0, f32x4 v1, const L1u& l) { f32x4 h0, h1; unpack8v(l.a, h0, h1);
#pragma unroll
        for (int e = 0; e < 4; ++e) { h0[e] = fmaxf(h0[e], 1e-30f); h1[e] = fmaxf(h1[e], 1e-30f); }
        *(u32x4*)(merged + (size_t)row * 1024 + col0) = pack8v(v0 * h0, v1 * h1); };
    run_gemm_chain<L4, 4, L1u, 16, 2>(smem, (const bf16_t*)(ws + OFF_PR), (const bf16_t*)(ws + OFF_W28), (const bf16_t*)(ws + OFF_ZR), (const bf16_t*)(ws + OFF_WHY), T_, 1024, opqs(512), mpre, mpost, pre, post);
}

DEV void phase5(CParams& p, unsigned char* smem) {
    unsigned char* ws = opqp(PWS);
    const float* x = PIN(0);
    bf16_t* x1b = (bf16_t*)(ws + OFF_HN);
    auto pre = [=](int row, int col0) { const size_t o = (size_t)row * 1024 + col0; L2q l; l.a = *(const f32x4*)(x + o); l.b = *(const f32x4*)(x + o + 4); return l; };
    auto f = [=](int row, int col0, f32x4 v0, f32x4 v1, const L2q& l) { const size_t o = (size_t)row * 1024 + col0;
        const f32x4 a = l.a + v0, b = l.b + v1;
        *(u32x4*)(x1b + o) = pack8v(a, b); };
    run_gemm_b<L2q, 8>(smem, (const bf16_t*)(ws + OFF_MERGED), (const bf16_t*)(ws + OFF_WOUT), T_, 1024, 1024, pre, f);
}

DEV void phase7(CParams& p, unsigned char* smem) {
    unsigned char* ws = opqp(PWS);
    bf16_t* qg = (bf16_t*)POUT;
    const float* xrs = (const float*)(ws + OFF_XRS); const float* wss = (const float*)(ws + OFF_WSS);
    typedef int i32x4_t __attribute__((ext_vector_type(4)));
    struct LS { float x; f32x4 w0, w1; };
    auto pre = [=](int row, int col0) { LS l; l.x = xrs[row]; l.w0 = *(const f32x4*)(wss + col0); l.w1 = *(const f32x4*)(wss + col0 + 4); return l; };
    auto f = [=](int row, int col0, f32x4 v0, f32x4 v1, const LS& l) { const i32x4_t i0 = __builtin_bit_cast(i32x4_t, v0), i1 = __builtin_bit_cast(i32x4_t, v1);
        *(u32x4*)(qg + (size_t)row * 2048 + col0) = pack8v(__builtin_convertvector(i0, f32x4) * l.x * l.w0, __builtin_convertvector(i1, f32x4) * l.x * l.w1); };
    run_gemm_b<LS, 8, 2>(smem, (const bf16_t*)(ws + OFF_XR8), (const bf16_t*)(ws + OFF_WS8), T_, 2048, 512, pre, f);
}

DEV int mono(float x) { const int b = __float_as_int(x); return b ^ ((b >> 31) & 0x7fffffff); }
DEV float unmono(int k) { return __int_as_float(k ^ ((k >> 31) & 0x7fffffff)); }
#define INS16(Lk, v_) { int vv_ = (v_); _Pragma("unroll") for (int p_ = 0; p_ < 16; ++p_) { const int hi_ = max(Lk[p_], vv_); vv_ = min(Lk[p_], vv_); Lk[p_] = hi_; } }

#define CE_(a, b) { const int hi_ = max(a, b), lo_ = min(a, b); a = hi_; b = lo_; }
template <int N> DEV void bsort_desc(int (&v)[N]) {
#pragma unroll
    for (int k = 2; k <= N; k <<= 1)
#pragma unroll
        for (int j = k >> 1; j > 0; j >>= 1)
#pragma unroll
            for (int i = 0; i < N; ++i) { const int l = i ^ j; if (l > i) { if ((i & k) == 0) CE_(v[i], v[l]) else CE_(v[l], v[i]) } }
}
DEV void bmerge16(int (&v)[16]) {
#pragma unroll
    for (int j = 8; j > 0; j >>= 1)
#pragma unroll
        for (int i = 0; i < 16; ++i) { const int l = i ^ j; if (l > i) CE_(v[i], v[l]) }
}
template <int LO, int N, int R> DEV void oem_merge(int (&v)[32]) {
    if constexpr (2 * R < N) {
        oem_merge<LO, N, 2 * R>(v); oem_merge<LO + R, N, 2 * R>(v);
#pragma unroll
        for (int i = LO + R; i + R < LO + N; i += 2 * R) CE_(v[i], v[i + R])
    } else CE_(v[LO], v[LO + R])
}
template <int LO, int N> DEV void oem_sort(int (&v)[32]) {
    if constexpr (N > 1) { oem_sort<LO, N / 2>(v); oem_sort<LO + N / 2, N / 2>(v); oem_merge<LO, N, 1>(v); }
}
template <int CTRL> DEV void quad_merge16(int (&v)[16]) {
    int m[16];
#pragma unroll
    for (int i = 0; i < 16; ++i) m[i] = __builtin_amdgcn_update_dpp(0, v[15 - i], CTRL, 0xf, 0xf, false);
#pragma unroll
    for (int i = 0; i < 16; ++i) v[i] = max(v[i], m[i]);
    bmerge16(v);
}

DEV void phase8(CParams& p, unsigned char* smem) {
    const int tid = opq((int)threadIdx.x), lane = tid & 63, w = tid >> 6, r = lane & 15, q = lane >> 4;
    unsigned char* ws = opqp(PWS);
    float* sc = (float*)smem;
    int* tops = (int*)(smem + 67584);
    unsigned char* ctab = smem + 75776;
    const bf16_t* qg = (const bf16_t*)POUT;
    int* idxg = (int*)(ws + OFF_IDX); float* gg = (float*)(ws + OFF_G);
    __syncthreads();
    if (tid < 64) {
        const int L = tid >> 4, k = tid & 15; int v = 0xff;
        if (L == 0) v = k;
        else if (L == 1) v = k < 8 ? (1 << 4) | k : k < 12 ? (3 << 4) | (k - 8) : k < 15 ? (4 << 4) | (k - 12) : (8 << 4);
        else if (L == 2) v = k < 5 ? (2 << 4) | k : k < 11 ? ((5 + ((k - 5) >> 1)) << 4) | ((k - 5) & 1) : ((9 + (k - 11)) << 4);
        else v = k < 2 ? ((14 + k) << 4) : 0xff;
        ctab[tid] = (unsigned char)v;
    }
    pg8::StaticOrder SO; SO.init(T_, 2048, NBLK(), BID());
    auto item_of = [&](int j, int& tt, int& h) -> bool { pg8::Unit u; if (!SO.next(j >> 2, u)) return false; tt = u.pm * 4 + (j & 3); h = u.pn; return true; };
    u32x4 qreg[4];
    const int qtok = tid >> 3, qch = tid & 7;
    int* tops1 = (int*)(smem + 108608);
    int tt = 0, h = 0;
    bool have = item_of(0, tt, h);
    if (have) {
#pragma unroll
        for (int i = 0; i < 4; ++i) qreg[i] = *(const u32x4*)(qg + (size_t)(64 * tt + qtok) * 2048 + h * 256 + 8 * (qch + 8 * i));
    }
    for (int j = 0; have; j += 2) {
        int t0s[2], hs_[2]; bool haveB = false;
#pragma unroll
        for (int sub = 0; sub < 2; ++sub) {
            if (sub == 1 && !have) break;
            if (sub == 1) haveB = true;
            int* topw = sub ? tops1 : tops;
            const int jj = j + sub;
            t0s[sub] = 64 * tt; hs_[sub] = h;
            __syncthreads();
#pragma unroll
            for (int i = 0; i < 4; ++i) { const int col = 8 * (qch + 8 * i), c_ = col >> 7, k_ = col & 127;
                *(u32x4*)((bf16_t*)sc + (c_ * 64 + qtok) * 136 + k_) = qreg[i]; }
            __syncthreads();
            have = item_of(jj + 1, tt, h);
            if (have) {
#pragma unroll
                for (int i = 0; i < 4; ++i) qreg[i] = *(const u32x4*)(qg + (size_t)(64 * tt + qtok) * 2048 + h * 256 + 8 * (qch + 8 * i));
            }
            {
                const int row = tid >> 2, qd = tid & 3;
                const bf16_t* src = (const bf16_t*)sc + row * 136 + 32 * qd;
                int v[32];
#pragma unroll
                for (int k8 = 0; k8 < 4; ++k8) { f32x4 x0, x1; unpack8v(*(const u32x4*)(src + 8 * k8), x0, x1);
#pragma unroll
                    for (int e = 0; e < 4; ++e) { v[8 * k8 + e] = (mono(x0[e]) & ~127) | (32 * qd + 8 * k8 + e); v[8 * k8 + 4 + e] = (mono(x1[e]) & ~127) | (32 * qd + 8 * k8 + 4 + e); } }
                oem_sort<0, 16>(v); oem_sort<16, 16>(v);
                int t16[16];
#pragma unroll
                for (int i = 0; i < 16; ++i) t16[i] = max(v[i], v[31 - i]);
                bmerge16(t16);
                quad_merge16<0xB1>(t16); quad_merge16<0x4E>(t16);
                if (qd == 0) {
#pragma unroll
                    for (int k4 = 0; k4 < 4; ++k4) *(u32x4*)(topw + row * 16 + 4 * k4) = (u32x4){(unsigned)t16[4 * k4], (unsigned)t16[4 * k4 + 1], (unsigned)t16[4 * k4 + 2], (unsigned)t16[4 * k4 + 3]};
                }
            }
        }
        __syncthreads();
        const bool second = tid >= 256;
        if (!second || haveB) {
            const int t2 = tid & 255, tok = t2 >> 2, L = t2 & 3;
            const int* tsel = second ? tops1 : tops;
            const int t0 = second ? t0s[1] : t0s[0], h_cur = second ? hs_[1] : hs_[0];
            const int* ta = tsel + tok * 16; const int* tb = tsel + (64 + tok) * 16;
            int m[16];
#pragma unroll
            for (int k = 0; k < 16; ++k) { const int cij = ctab[L * 16 + k];
                const float sa = unmono(ta[(cij >> 4) & 15] & ~127), sb = unmono(tb[cij & 15] & ~127);
                m[k] = cij == 0xff ? (int)0x80000000 : ((mono(sa + sb) & ~255) | cij); }
            bsort_desc<16>(m);
            quad_merge16<0xB1>(m); quad_merge16<0x4E>(m);
            {
                u32x4 ex; f32x4 e;
#pragma unroll
                for (int j = 0; j < 4; ++j) { const int mk = L == 0 ? m[j] : L == 1 ? m[4 + j] : L == 2 ? m[8 + j] : m[12 + j];
                    e[j] = unmono(mk & ~255); ex[j] = (unsigned)((ta[(mk >> 4) & 15] & 127) * 128 + (tb[mk & 15] & 127)); }
                const size_t ob = (size_t)(t0 + tok) * 128 + h_cur * 16 + 4 * L;
                *(u32x4*)(idxg + ob) = ex; *(f32x4*)(gg + ob) = e;
            }
        }
    }
}

DEV void unpack8(u32x4 v, float* o) { o[0] = bf_lo(v.x); o[1] = bf_hi(v.x); o[2] = bf_lo(v.y); o[3] = bf_hi(v.y); o[4] = bf_lo(v.z); o[5] = bf_hi(v.z); o[6] = bf_lo(v.w); o[7] = bf_hi(v.w); }
DEV void unpack_fp8x16(u32x4 v, float* o) {
#pragma unroll
    for (int d = 0; d < 4; ++d) { const f32x2 lo = __builtin_amdgcn_cvt_pk_f32_fp8((int)v[d], false), hi = __builtin_amdgcn_cvt_pk_f32_fp8((int)v[d], true);
        o[4 * d] = lo.x; o[4 * d + 1] = lo.y; o[4 * d + 2] = hi.x; o[4 * d + 3] = hi.y; }
}
template <int CTRL> DEV float dpp_mov(float v) { return __int_as_float(__builtin_amdgcn_update_dpp(0, __float_as_int(v), CTRL, 0xf, 0xf, false)); }
DEV float row_allreduce16(float v) {
    v += dpp_mov<0x128>(v); v += dpp_mov<0x124>(v); v += dpp_mov<0x122>(v); v += dpp_mov<0x121>(v); return v;
}
struct Place { int nx, vx, nloc, rank; };
template <int CTRL> DEV float dppf(float v) { return __int_as_float(__builtin_amdgcn_update_dpp(0, __float_as_int(v), CTRL, 0xf, 0xf, false)); }

DEV float wave_sum_dpp(float v) {
    v += dppf<0x128>(v); v += dppf<0x124>(v); v += dppf<0x122>(v); v += dppf<0x121>(v);
    const int b = __float_as_int(v);
    return __int_as_float(__builtin_amdgcn_readlane(b, 0)) + __int_as_float(__builtin_amdgcn_readlane(b, 16)) + __int_as_float(__builtin_amdgcn_readlane(b, 32)) + __int_as_float(__builtin_amdgcn_readlane(b, 48));
}
template <int CTRL> DEV int dppi(int v) { return __builtin_amdgcn_update_dpp(0, v, CTRL, 0xf, 0xf, false); }
typedef __attribute__((address_space(1))) unsigned char* gbptr;
DEV gbptr uni_base(const unsigned char* q) { const unsigned long long v = (unsigned long long)q; const unsigned lo = __builtin_amdgcn_readfirstlane((unsigned)v), hi = __builtin_amdgcn_readfirstlane((unsigned)(v >> 32));
    return (gbptr)(((unsigned long long)hi << 32) | lo); }
#define GLD(TYPE, BASE, OFF) (*(const __attribute__((address_space(1))) TYPE*)((BASE) + (unsigned)(OFF)))
#define GST(TYPE, BASE, OFF) (*(__attribute__((address_space(1))) TYPE*)((BASE) + (unsigned)(OFF)))
DEV void quant_x1(CParams& p) {
    const int tid = opq((int)threadIdx.x); const int lane = tid & 63, wave = tid >> 6;
    unsigned char* ws = opqp(PWS);
    const bf16_t* x1b = (const bf16_t*)(ws + OFF_HN); unsigned char* xq = ws + OFF_XQ; float* hsg = (float*)(ws + OFF_HS); float* ssf = (float*)(ws + OFF_SS1);
    const int nb_ = NBLK(), bid_ = BID();
    const bool grp_ = nb_ == 256;
    const int rstep = grp_ ? 4 : nb_ * 32, rfirst = grp_ ? 2048 * (bid_ & 7) + 64 * (bid_ >> 3) + 8 * wave : (bid_ * 8 + wave) * 4, rend = grp_ ? rfirst + 8 : T_;
    for (int row0 = rfirst; row0 < rend; row0 += rstep) {
        u32x4 h0[4], h1[4];
#pragma unroll
        for (int k = 0; k < 4; ++k) { h0[k] = *(const u32x4*)(x1b + (size_t)(row0 + k) * 1024 + 16 * lane); h1[k] = *(const u32x4*)(x1b + (size_t)(row0 + k) * 1024 + 16 * lane + 8); }
#pragma unroll
        for (int k = 0; k < 4; ++k) { float hf[16];
            hf[0] = bf_lo(h0[k].x); hf[1] = bf_hi(h0[k].x); hf[2] = bf_lo(h0[k].y); hf[3] = bf_hi(h0[k].y); hf[4] = bf_lo(h0[k].z); hf[5] = bf_hi(h0[k].z); hf[6] = bf_lo(h0[k].w); hf[7] = bf_hi(h0[k].w);
            hf[8] = bf_lo(h1[k].x); hf[9] = bf_hi(h1[k].x); hf[10] = bf_lo(h1[k].y); hf[11] = bf_hi(h1[k].y); hf[12] = bf_lo(h1[k].z); hf[13] = bf_hi(h1[k].z); hf[14] = bf_lo(h1[k].w); hf[15] = bf_hi(h1[k].w);
            float m_ = 0.f, sq_ = 0.f;
#pragma unroll
            for (int i = 0; i < 16; ++i) { m_ = fmaxf(m_, fabsf(hf[i])); sq_ += hf[i] * hf[i]; }
            sq_ = wave_sum_dpp(sq_); if (lane == 0) ssf[row0 + k] = sq_;
            { int mr = __float_as_int(m_); mr = max(mr, dppi<0x128>(mr)); mr = max(mr, dppi<0x124>(mr)); mr = max(mr, dppi<0x122>(mr)); mr = max(mr, dppi<0x121>(mr));
              mr = max(max(__builtin_amdgcn_readlane(mr, 0), __builtin_amdgcn_readlane(mr, 16)), max(__builtin_amdgcn_readlane(mr, 32), __builtin_amdgcn_readlane(mr, 48)));
              const float rm_ = __int_as_float(mr), ri_ = rm_ > 0.f ? 127.0f / rm_ : 0.f; u32x4 rv;
#pragma unroll
              for (int j = 0; j < 4; ++j) rv[j] = pack_i8x4(hf[4 * j], hf[4 * j + 1], hf[4 * j + 2], hf[4 * j + 3], ri_);
              *(u32x4*)(ws + OFF_XR8 + (size_t)(row0 + k) * 1024 + 16 * lane) = rv; if (lane == 0) ((float*)(ws + OFF_XRS))[row0 + k] = rm_ * (1.0f / 127.0f); }
            int mi = __float_as_int(m_);
            mi = max(mi, dppi<0xB1>(mi)); mi = max(mi, dppi<0x4E>(mi)); mi = max(mi, dppi<0x141>(mi));
            m_ = __int_as_float(mi);
            const float inv_ = m_ > 0.f ? 127.0f / m_ : 0.f;
            u32x4 qv;
#pragma unroll
            for (int j = 0; j < 4; ++j) qv[j] = pack_i8x4(hf[4 * j], hf[4 * j + 1], hf[4 * j + 2], hf[4 * j + 3], inv_);
            *(u32x4*)(xq + (size_t)(row0 + k) * 1024 + 16 * lane) = qv;
            if ((lane & 7) == 0) hsg[(row0 + k) * 8 + (lane >> 3)] = m_ * (1.0f / 127.0f); }
    }
}
#define P9_HTAKE() { hq[0] = (int)hn_.x; hq[1] = (int)hn_.y; hq[2] = (int)hn_.z; hq[3] = (int)hn_.w; hs = hsn_; }
#define P9_COMP(D, OUT) { int tt[8]; _Pragma("unroll") for (int k = 0; k < 8; ++k) { int a_ = __builtin_amdgcn_sdot4((int)D[k][0], hq[0], 0, false); a_ = __builtin_amdgcn_sdot4((int)D[k][1], hq[1], a_, false); \
        a_ = __builtin_amdgcn_sdot4((int)D[k][2], hq[2], a_, false); tt[k] = __builtin_amdgcn_sdot4((int)D[k][3], hq[3], a_, false); } \
    const int v0_ = tt[0] + dppi<0x141>(tt[4]), v1_ = tt[1] + dppi<0x141>(tt[5]), v2_ = tt[2] + dppi<0x141>(tt[6]), v3_ = tt[3] + dppi<0x141>(tt[7]); \
    const int w0_ = (b1 ? v2_ : v0_) + dppi<0x4E>(b1 ? v0_ : v2_), w1_ = (b1 ? v3_ : v1_) + dppi<0x4E>(b1 ? v1_ : v3_); \
    OUT = (b0 ? w1_ : w0_) + dppi<0xB1>(b0 ? w0_ : w1_); }
#define P11_COMP(D, W) { _Pragma("unroll") for (int st = 0; st < 2; ++st) { _Pragma("unroll") for (int j = 0; j < 4; ++j) { \
        const unsigned a_ = D[4 * st][j], b_ = D[4 * st + 1][j], c_ = D[4 * st + 2][j], d_ = D[4 * st + 3][j]; \
        const unsigned p_ = __builtin_amdgcn_perm(b_, a_, 0x05010400u), pp_ = __builtin_amdgcn_perm(b_, a_, 0x07030602u), r_ = __builtin_amdgcn_perm(d_, c_, 0x05010400u), rr_ = __builtin_amdgcn_perm(d_, c_, 0x07030602u); \
        acc[4 * j]     = __builtin_amdgcn_sdot4((int)__builtin_amdgcn_perm(r_, p_, 0x05040100u), W[st], acc[4 * j], false); \
        acc[4 * j + 1] = __builtin_amdgcn_sdot4((int)__builtin_amdgcn_perm(r_, p_, 0x07060302u), W[st], acc[4 * j + 1], false); \
        acc[4 * j + 2] = __builtin_amdgcn_sdot4((int)__builtin_amdgcn_perm(rr_, pp_, 0x05040100u), W[st], acc[4 * j + 2], false); \
        acc[4 * j + 3] = __builtin_amdgcn_sdot4((int)__builtin_amdgcn_perm(rr_, pp_, 0x07060302u), W[st], acc[4 * j + 3], false); } } }
DEV int swap_add32(int a, int b) { const auto r = __builtin_amdgcn_permlane32_swap((unsigned)a, (unsigned)b, false, false); return (int)(r[0] + r[1]); }
DEV int swap_add16(int a, int b) { const auto r = __builtin_amdgcn_permlane16_swap((unsigned)a, (unsigned)b, false, false); return (int)(r[0] + r[1]); }
#define TL_REQ_U(K) { const unsigned tb_ = ((unsigned)(((K) >> 1) & 7) << 9) + 256 * ((K) & 1); const u32x4 i0_ = *(const u32x4*)(idxl + tb_ + ioA), i1_ = *(const u32x4*)(idxl + tb_ + ioB); \
    r_ie[0] = (int)i0_.x; r_ie[1] = (int)i0_.y; r_ie[2] = (int)i0_.z; r_ie[3] = (int)i0_.w; r_ie[4] = (int)i1_.x; r_ie[5] = (int)i1_.y; r_ie[6] = (int)i1_.z; r_ie[7] = (int)i1_.w; }
#define TL_HLOAD(N) { const unsigned t_ = (unsigned)(t0 + ((N) & 7)), s_ = (unsigned)(N) >> 3; hn_ = GLD(u32x4, xqb, (t_ << 10) + (s_ << 7) + l16); hsn_ = GLD(float, hsb, (t_ << 5) + (s_ << 2)); }
#define TL_ISSUE_U(D, K) { const gbptr ub_ = ub + ((size_t)((K) >> 4) << 21); _Pragma("unroll") for (int k = 0; k < 8; ++k) D[k] = GLD(u32x4, ub_, ((unsigned)r_ie[k] << 7) + l16); }
#define TL_REQ_V(K) { const unsigned tb_ = ((unsigned)(((K) >> 1) & 7) << 9) + 256 * ((K) & 1); const u32x4 i0_ = *(const u32x4*)(idxl + tb_ + g32), i1_ = *(const u32x4*)(idxl + tb_ + g32 + 16); \
    r_ie[0] = (int)i0_.x; r_ie[1] = (int)i0_.y; r_ie[2] = (int)i0_.z; r_ie[3] = (int)i0_.w; r_ie[4] = (int)i1_.x; r_ie[5] = (int)i1_.y; r_ie[6] = (int)i1_.z; r_ie[7] = (int)i1_.w; }
#define TL_ISSUE_V(D, K) { const gbptr vb_ = vb + ((size_t)((K) >> 4) << 21); _Pragma("unroll") for (int k = 0; k < 8; ++k) D[k] = GLD(u32x4, vb_, ((unsigned)r_ie[k] << 7) + l16); }
#define TL_STEP_U(DCUR, DNEXT, K, OUT) { if ((K) + 2 < 128) TL_ISSUE_U(DNEXT, (K) + 2); if ((K) + 3 < 128) TL_REQ_U((K) + 3); P9_COMP(DCUR, OUT); }
#define TL_STEP_V(DCUR, DNEXT, K) { const u32x2 w_ = *(const u32x2*)(wq + (((K) >> 1) & 7) * 128 + 64 * ((K) & 1) + g8);        \
    if ((K) + 2 < 128) TL_ISSUE_V(DNEXT, (K) + 2); if ((K) + 3 < 128) TL_REQ_V((K) + 3); int W_[2]; W_[0] = (int)w_.x; W_[1] = (int)w_.y; P11_COMP(DCUR, W_); }
#define TL_VOUT(N) { int n8[8], n4[4]; \
    _Pragma("unroll") for (int i = 0; i < 8; ++i) n8[i] = swap_add32(acc[i], acc[i + 8]); \
    _Pragma("unroll") for (int i = 0; i < 4; ++i) n4[i] = swap_add16(n8[i], n8[i + 4]); \
    const int f0 = (b3 ? n4[2] : n4[0]) + dppi<0x128>(b3 ? n4[0] : n4[2]), f1 = (b3 ? n4[3] : n4[1]) + dppi<0x128>(b3 ? n4[1] : n4[3]); \
    const float wscale = wscl[(N) & 7]; \
    GST(unsigned, pob, ((unsigned)(t0 + ((N) & 7)) << 11) + ((unsigned)((N) >> 3) << 8) + 2 * eoff) = pk2((float)f0 * wscale, (float)f1 * wscale); \
    _Pragma("unroll") for (int j = 0; j < 16; ++j) acc[j] = 0; }
DEV void phase_tail(CParams& p, unsigned char* smem) {
    const int tid = opq((int)threadIdx.x); const int lane = tid & 63, wave = __builtin_amdgcn_readfirstlane(tid >> 6), gi = lane >> 3, li = lane & 7;
    unsigned char* ws = opqp(PWS);
    const gbptr idxb = uni_base(ws + OFF_IDX), ub = uni_base(ws + OFF_U), vb = uni_base(ws + OFF_V), xqb = uni_base(ws + OFF_XQ), hsb = uni_base(ws + OFF_HS),
                ggb = uni_base(ws + OFF_G), pob = uni_base(ws + OFF_PO);
    const float* us = (const float*)(ws + OFF_US); const float* vs = (const float*)(ws + OFF_VS); const float* ssf = (const float*)(ws + OFF_SS1);
    const bf16_t* x1b = (const bf16_t*)(ws + OFF_HN); const float* gfin = PIN(20);
    float* dots = (float*)(smem + wave * 10240); unsigned char* wq = smem + wave * 10240 + 4096; float* wscl = (float*)(smem + wave * 10240 + 5120); const unsigned char* idxl = smem + wave * 10240 + 6144;
    const int q4 = (li >> 2) & 1; const bool b1 = (li & 2) != 0, b0 = (li & 1) != 0;
    const unsigned ioA = 4 * (8 * gi + 4 * q4), ioB = 4 * (8 * gi + 4 * (1 - q4));
    const unsigned l16 = 16 * li, g32 = 32 * gi, g8 = 8 * gi;
    const bool b3 = (lane & 8) != 0, b4 = (lane & 16) != 0, b5 = (lane & 32) != 0;
    const int eoff = 16 * li + (b5 ? 8 : 0) + (b4 ? 4 : 0) + (b3 ? 2 : 0);
    const float eps_ = __int_as_float(opq(__float_as_int(1e-6f)));
    const int nb_ = NBLK(), ostep = nb_ * 8; const bool grp_ = nb_ == 256;
    for (int oct = BID() * 8 + wave; oct < T_ / 8; oct += ostep) {
        const int t0 = grp_ ? 2048 * ((oct >> 3) & 7) + 64 * (oct >> 6) + 8 * (oct & 7) : oct * 8;
#pragma unroll
        for (int i = 0; i < 16; ++i) dots[i * 64 + lane] = 0.f;
#pragma unroll
        for (int i = 0; i < 4; ++i) *(u32x4*)(smem + wave * 10240 + 6144 + 1024 * i + 16 * lane) = GLD(u32x4, idxb, ((unsigned)t0 << 9) + 1024 * i + 16 * lane);
        int r_ie[8]; u32x4 D0[8], D1[8], D2[8], D3[8];
        {
            u32x4 hn_; float hsn_; int hq[4]; float hs;
            TL_REQ_U(0); TL_HLOAD(0); TL_ISSUE_U(D0, 0); TL_REQ_U(1); TL_ISSUE_U(D1, 1); TL_REQ_U(2);
            P9_HTAKE();
#pragma unroll 1
            for (int k0 = 0; k0 < 128; k0 += 4) {
                const int n = k0 >> 1;
                int o0, o1;
                TL_STEP_U(D0, D2, k0, o0);
                TL_HLOAD(n + 1);
                TL_STEP_U(D1, D3, k0 + 1, o1);
                { float* dp = dots + (n & 7) * 128 + lane; dp[0] += (float)o0 * hs; dp[64] += (float)o1 * hs; }
                P9_HTAKE();
                TL_STEP_U(D2, D0, k0 + 2, o0);
                if (n + 2 < 64) TL_HLOAD(n + 2);
                TL_STEP_U(D3, D1, k0 + 3, o1);
                { float* dp = dots + ((n + 1) & 7) * 128 + lane; dp[0] += (float)o0 * hs; dp[64] += (float)o1 * hs; }
                if (n + 2 < 64) P9_HTAKE();
            }
        }
        TL_REQ_V(0); TL_ISSUE_V(D0, 0); TL_REQ_V(1); TL_ISSUE_V(D1, 1); TL_REQ_V(2);
#pragma unroll
        for (int tk = 0; tk < 8; ++tk) {
            const unsigned t = (unsigned)(t0 + tk);
            const int e0 = GLD(int, idxb, (t << 9) + 4 * lane), e1 = GLD(int, idxb, (t << 9) + 256 + 4 * lane);
            const float s0 = GLD(float, ggb, (t << 9) + 4 * lane), s1 = GLD(float, ggb, (t << 9) + 256 + 4 * lane);
            const float rs = rsqrtf(ssf[t] * (1.0f / 1024.0f) + 1e-6f);
            float g0, g1;
            { float mx0 = s0, mx1 = s1;
              mx0 = fmaxf(mx0, dppf<0x128>(mx0)); mx0 = fmaxf(mx0, dppf<0x124>(mx0)); mx0 = fmaxf(mx0, dppf<0x122>(mx0)); mx0 = fmaxf(mx0, dppf<0x121>(mx0));
              mx1 = fmaxf(mx1, dppf<0x128>(mx1)); mx1 = fmaxf(mx1, dppf<0x124>(mx1)); mx1 = fmaxf(mx1, dppf<0x122>(mx1)); mx1 = fmaxf(mx1, dppf<0x121>(mx1));
              const float e0_ = __expf(rs * (s0 - mx0)), e1_ = __expf(rs * (s1 - mx1));
              g0 = e0_ / row_allreduce16(e0_); g1 = e1_ / row_allreduce16(e1_); }
            const float x0 = dots[tk * 128 + lane] * us[e0] * rs, x1 = dots[tk * 128 + 64 + lane] * us[e1] * rs;
            const float w0 = g0 * 0.5f * x0 * (1.0f + erff(x0 * 0.70710678118654752f)) * vs[e0], w1 = g1 * 0.5f * x1 * (1.0f + erff(x1 * 0.70710678118654752f)) * vs[e1];
            int mi = __float_as_int(fmaxf(fabsf(w0), fabsf(w1)));
            mi = max(mi, dppi<0x128>(mi)); mi = max(mi, dppi<0x124>(mi)); mi = max(mi, dppi<0x122>(mi)); mi = max(mi, dppi<0x121>(mi));
            mi = max(max(__builtin_amdgcn_readlane(mi, 0), __builtin_amdgcn_readlane(mi, 16)), max(__builtin_amdgcn_readlane(mi, 32), __builtin_amdgcn_readlane(mi, 48)));
            const float m = __int_as_float(mi);
            const float inv = m > 0.f ? 127.0f / m : 0.f;
            wq[tk * 128 + lane] = (unsigned char)__float_as_uint(fmaf(w0, inv, 12582912.0f)); wq[tk * 128 + 64 + lane] = (unsigned char)__float_as_uint(fmaf(w1, inv, 12582912.0f));
            if (lane == 0) wscl[tk] = m * (1.0f / 127.0f);
        }
        {
            int acc[16];
#pragma unroll
            for (int j = 0; j < 16; ++j) acc[j] = 0;
#pragma unroll 1
            for (int k0 = 0; k0 < 128; k0 += 4) {
                const int n = k0 >> 1;
                TL_STEP_V(D0, D2, k0);
                TL_STEP_V(D1, D3, k0 + 1);
                TL_VOUT(n);
                TL_STEP_V(D2, D0, k0 + 2);
                TL_STEP_V(D3, D1, k0 + 3);
                TL_VOUT(n + 1);
            }
        }
        asm volatile("s_waitcnt vmcnt(0)" ::: "memory");
        __builtin_amdgcn_fence(__ATOMIC_SEQ_CST, "workgroup");
#pragma unroll 1
        for (int r4 = 0; r4 < 2; ++r4) {
            const int row0 = t0 + 4 * r4;
            f32x4 v[4][4]; float ss[4];
#pragma unroll
            for (int k = 0; k < 4; ++k)
#pragma unroll
                for (int i = 0; i < 4; ++i) { const u32x2 xv = *(const u32x2*)(x1b + (size_t)(row0 + k) * 1024 + 4 * lane + 256 * i);
                    const u32x2 pv = GLD(u32x2, pob, ((unsigned)(row0 + k) << 11) + 8 * lane + 512 * i);
                    v[k][i] = (f32x4){bf_lo(xv.x), bf_hi(xv.x), bf_lo(xv.y), bf_hi(xv.y)} + (f32x4){bf_lo(pv.x), bf_hi(pv.x), bf_lo(pv.y), bf_hi(pv.y)}; }
#pragma unroll
            for (int k = 0; k < 4; ++k) { ss[k] = 0.f;
#pragma unroll
                for (int i = 0; i < 4; ++i) ss[k] += v[k][i][0] * v[k][i][0] + v[k][i][1] * v[k][i][1] + v[k][i][2] * v[k][i][2] + v[k][i][3] * v[k][i][3]; }
#pragma unroll
            for (int o = 32; o; o >>= 1) {
#pragma unroll
                for (int k = 0; k < 4; ++k) ss[k] += __shfl_xor(ss[k], o); }
#pragma unroll
            for (int i = 0; i < 4; ++i) { const f32x4 gv = *(const f32x4*)(gfin + 4 * lane + 256 * i);
#pragma unroll
                for (int k = 0; k < 4; ++k) { const float sc = rsqrtf(ss[k] * (1.0f / 1024.0f) + eps_);
                    *(f32x4*)(POUT + (size_t)(row0 + k) * 1024 + 4 * lane + 256 * i) = v[k][i] * sc * gv; } }
        }
    }
}

#define LAS __attribute__((address_space(3)))
#define XB_TMO      128
#define XB_XCNT(j)  (256  + 64 * (j))
#define XB_XSUB(j)  (1280 + 64 * (j))
#define XB_XGEN(j)  (2304 + 64 * (j))
#define XB_TOP      3328
#define XB_TOPGEN   3392
#define XCD_BAR_WORDS 3456
#define XB_SPIN_CAP (1u << 18)

__device__ __forceinline__ unsigned xb_ld(unsigned* p)              { return __hip_atomic_load(p, __ATOMIC_RELAXED, __HIP_MEMORY_SCOPE_AGENT); }
__device__ __forceinline__ unsigned xb_add(unsigned* p, unsigned v) { return __hip_atomic_fetch_add(p, v, __ATOMIC_RELAXED, __HIP_MEMORY_SCOPE_AGENT); }
__device__ __forceinline__ unsigned xb_xcc_id() { return (unsigned)__builtin_amdgcn_s_getreg((3 << 11) | 20) & 0xFu; }
#define XB_SPIN(cond, bar) do { unsigned _sp = 0; while (cond) { __builtin_amdgcn_s_sleep(1); \
    if ((++_sp & 255u) == 0u) { if (xb_ld(&(bar)[XB_TMO])) break; if (_sp > XB_SPIN_CAP) { atomicAdd(&(bar)[XB_TMO], 1u); break; } } } } while (0)

struct XcdBarrier {
    unsigned* bar; unsigned x;
    volatile LAS unsigned* st;
};

__device__ __forceinline__ XcdBarrier xcd_barrier_post(unsigned* bar, volatile LAS unsigned* st) {
    XcdBarrier b; b.bar = bar; b.x = xb_xcc_id(); b.st = st;
    if (threadIdx.x == 0) (void)xb_add(&bar[XB_XCNT(b.x)], 1u);
    return b;
}
__device__ __forceinline__ void xcd_barrier_complete(unsigned* bar, unsigned x, unsigned& nloc, unsigned& nx) {
    const unsigned G = NBLK() * gridDim.y * gridDim.z;
    unsigned sum, cnt, mine, sp = 0u;
    for (;;) {
        sum = 0u; cnt = 0u; mine = 0u;
#pragma unroll 1
        for (unsigned j = 0; j < 16; ++j) { const unsigned c = xb_ld(&bar[XB_XCNT(j)]); sum += c; cnt += (c > 0u) ? 1u : 0u; mine = (j == x) ? c : mine; }
        if (sum == G) break;
        __builtin_amdgcn_s_sleep(1);
        if ((++sp & 255u) == 0u) { if (xb_ld(&bar[XB_TMO])) break; if (sp > XB_SPIN_CAP) { atomicAdd(&bar[XB_TMO], 1u); break; } }
    }
    nloc = mine > 0u ? mine : 1u; nx = cnt > 0u ? cnt : 1u;
}

__device__ __forceinline__ void xcd_barrier(const XcdBarrier& b) {
    asm volatile("s_waitcnt vmcnt(0)" ::: "memory");
    __syncthreads();
    if (threadIdx.x == 0) {
        unsigned* bar = b.bar;
        __builtin_amdgcn_s_waitcnt(0);
        unsigned nloc = b.st[0], nx = b.st[1];
        if (nloc == 0u) { xcd_barrier_complete(bar, (unsigned)opqs((int)b.x), nloc, nx); b.st[0] = nloc; b.st[1] = nx; }
        const unsigned old = xb_add(&bar[XB_XSUB(b.x)], 1u);
        const unsigned gen = old / nloc;
        if (old + 1u == (gen + 1u) * nloc) {
            __builtin_amdgcn_fence(__ATOMIC_RELEASE, "agent");
            asm volatile("s_waitcnt vmcnt(0)" ::: "memory");
            const unsigned og = xb_add(&bar[XB_TOP], 1u);
            const unsigned tg = og / nx;
            if (og + 1u == (tg + 1u) * nx) xb_add(&bar[XB_TOPGEN], 1u);
            else XB_SPIN(xb_ld(&bar[XB_TOPGEN]) == tg, bar);
            __builtin_amdgcn_fence(__ATOMIC_ACQUIRE, "agent");
            xb_add(&bar[XB_XGEN(b.x)], 1u);
            asm volatile("s_waitcnt vmcnt(0)" ::: "memory");
        } else {
            XB_SPIN(xb_ld(&bar[XB_XGEN(b.x)]) == gen, bar);
            __builtin_amdgcn_fence(__ATOMIC_ACQUIRE, "agent");
            asm volatile("s_waitcnt vmcnt(0)" ::: "memory");
        }
    }
    __syncthreads();
}


#define XB_RANK(j)  (3520 + 64 * (j))
#define GRP_SUB(g)  (5120 + 64 * (g))
#define GRP_GEN(g)  (5632 + 64 * (g))
#define GRP_XM(g)   (6144 + 64 * (g))
__device__ __forceinline__ void grp_barrier(unsigned* bar, unsigned g, unsigned n) {
    asm volatile("s_waitcnt vmcnt(0)" ::: "memory");
    __syncthreads();
    if (threadIdx.x == 0) {
        __builtin_amdgcn_s_waitcnt(0);
        const unsigned old = xb_add(&bar[GRP_SUB(g)], 1u);
        const unsigned gen = old / n;
        if (old + 1u == (gen + 1u) * n) xb_add(&bar[GRP_GEN(g)], 1u);
        else XB_SPIN(xb_ld(&bar[GRP_GEN(g)]) == gen, bar);
        __builtin_amdgcn_fence(__ATOMIC_ACQUIRE, "agent");
        asm volatile("s_waitcnt vmcnt(0)" ::: "memory");
    }
    __syncthreads();
}
DEV Place get_place(const XcdBarrier& b, volatile LAS unsigned* bst, unsigned char* ws, bool multi) {
    Place pl;
    if (!multi) { pl.nx = 1; pl.vx = 0; pl.nloc = (int)NBLK(); pl.rank = (int)BID(); return pl; }
    __syncthreads();
    if (threadIdx.x == 0) {
        unsigned* bar = (unsigned*)(ws + OFF_BAR); unsigned nx = 0, vx = 0, mine = 1; const unsigned myx = (unsigned)opqs((int)b.x);
#pragma unroll 1
        for (unsigned j = 0; j < 16; ++j) { const unsigned c = xb_ld(&bar[XB_XCNT(j)]); nx += c > 0u ? 1u : 0u; vx += (c > 0u && j < myx) ? 1u : 0u; mine = (j == myx && c > 0u) ? c : mine; }
        if (nx == 0u) nx = 1u;
        if (nx > 8u) { vx = vx % 8u; nx = 8u; }
        bst[3] = nx; bst[4] = vx; bst[5] = mine;
    }
    __syncthreads();
    pl.nx = (int)bst[3]; pl.vx = (int)bst[4]; pl.nloc = (int)bst[5]; pl.rank = (int)bst[2];
    if (pl.rank >= pl.nloc) pl.rank = pl.rank % pl.nloc;
    return pl;
}

__global__ void __launch_bounds__(NT) fwd_kernel(Params p_arg) {
    __shared__ __attribute__((aligned(16))) unsigned char smem[SMEM_BYTES];
    CParams* kp = (CParams*)__builtin_amdgcn_kernarg_segment_ptr();
    const int ph_lo = kp->ph_lo, ph_hi = kp->ph_hi;
    volatile LAS unsigned* bst = (volatile LAS unsigned*)((LAS unsigned char*)smem + 131072 + 256);
    if (threadIdx.x == 0) { bst[0] = 0u; bst[1] = 0u; bst[6] = 0u; }
    __syncthreads();
    XcdBarrier xbar{};
    const bool multi = ph_hi - ph_lo > 1;
    if (multi) {
        xbar = xcd_barrier_post((unsigned*)(((unsigned char*)kp->ws) + OFF_BAR), bst);
        if (threadIdx.x == 0) bst[2] = xb_add((unsigned*)(((unsigned char*)kp->ws) + OFF_BAR) + XB_RANK(xbar.x), 1u);
        if (threadIdx.x == 0) __hip_atomic_fetch_or((unsigned*)(((unsigned char*)kp->ws) + OFF_BAR) + GRP_XM(blockIdx.x & 7u), 1u << xbar.x, __ATOMIC_RELAXED, __HIP_MEMORY_SCOPE_AGENT);
    }
#define RUN_PHASE(K, CALL) if (ph_lo <= (K) && (K) < ph_hi) { asm volatile("" : "+s"(kp)); CParams& p = *kp; CALL; if ((K) + 1 < ph_hi) xcd_barrier(xbar); }
    RUN_PHASE(0, phase0(p, smem))
    RUN_PHASE(1, phase1(p, smem))
    RUN_PHASE(2, phase2(p, smem))
    if (multi && ph_lo <= 2 && 3 < ph_hi) {
        if (threadIdx.x == 0) { unsigned* bar = (unsigned*)(((unsigned char*)kp->ws) + OFF_BAR); unsigned ok = (NBLK() == 256) ? 1u : 0u;
#pragma unroll 1
            for (unsigned g = 0; g < 8; ++g) { const unsigned m = xb_ld(&bar[GRP_XM(g)]); ok &= (m != 0u && (m & (m - 1u)) == 0u) ? 1u : 0u; }
            bst[6] = ok; }
        __syncthreads();
    }
#define RUN_PHASE_G(K, CALL) if (ph_lo <= (K) && (K) < ph_hi) { asm volatile("" : "+s"(kp)); CParams& p = *kp; CALL; if ((K) + 1 < ph_hi) { \
        if (ph_lo <= 2 && bst[6] != 0u && (K) != 3) grp_barrier((unsigned*)(((unsigned char*)kp->ws) + OFF_BAR), blockIdx.x & 7u, 32u); else xcd_barrier(xbar); } }
    RUN_PHASE_G(3, phase3(p, smem))
    RUN_PHASE_G(4, phase4(p, smem))
    RUN_PHASE_G(5, phase5(p, smem))
    RUN_PHASE_G(6, quant_x1(p))
    RUN_PHASE_G(7, { phase7(p, smem); asm volatile("s_waitcnt vmcnt(0)" ::: "memory"); __syncthreads(); phase8(p, smem); })
    RUN_PHASE(8, phase_tail(p, smem))
#undef RUN_PHASE_G
#undef RUN_PHASE
}

extern "C" void kernel_launch(void* const* d_in, const int* in_sizes, int n_in, void* d_out, int out_size, void* d_ws, size_t ws_size, hipStream_t stream) {
    static int grid = 0;
    if (grid == 0) {
        if (n_in != 21 || out_size != T_ * 1024 || ws_size < WS_NEED) { fprintf(stderr, "kernel_launch: unexpected problem (n_in %d, out %d, ws %zu)\n", n_in, out_size, ws_size); grid = -1; return; }
        int dev = 0, cus = 0, per_cu = 0;
        (void)hipGetDevice(&dev);
        (void)hipDeviceGetAttribute(&cus, hipDeviceAttributeMultiprocessorCount, dev);
        (void)hipOccupancyMaxActiveBlocksPerMultiprocessor(&per_cu, (const void*)fwd_kernel, NT, 0);
        if (per_cu < 1 || cus < 1) { fprintf(stderr, "kernel_launch: occupancy query says %d blocks/CU on %d CUs\n", per_cu, cus); grid = -1; return; }
        grid = cus > 256 ? 256 : cus;
    }
    if (grid < 0) return;
    Params p{};
    for (int i = 0; i < 21; ++i) p.in[i] = (const float*)d_in[i];
    p.out = (float*)d_out; p.ws = (unsigned char*)d_ws;
#if N_LAUNCHES == 1
    p.ph_lo = 0; p.ph_hi = NPHASE;
    (void)hipMemsetAsync((unsigned char*)d_ws + OFF_BAR, 0, 32768, stream);
    void* args[] = {&p};
    hipError_t e = hipLaunchCooperativeKernel((const void*)fwd_kernel, dim3(grid), dim3(NT), args, 0, stream);
    if (e != hipSuccess) fprintf(stderr, "cooperative launch failed: %s (grid %d)\n", hipGetErrorString(e), grid);
#else
    for (int ph = 0; ph < NPHASE; ++ph) { p.ph_lo = ph; p.ph_hi = ph + 1;
        hipLaunchKernelGGL(fwd_kernel, dim3(grid), dim3(NT), 0, stream, p); }
#endif
}
```
